# Optimizing an MI355X kernel written in HIP

```python
import math
import jax, jax.numpy as jnp
from jax import lax
import numpy as np

D_MODEL = 1024
BATCH = 2
SEQ = 8192
DEPTH = 1

N_META = 16
EPS = 1e-6
GLA_HEADS = 4
GLA_DK = 128
GLA_DV = 256
GLA_LOWRANK = 16
GLA_TAU = 16.0
GLA_CHUNK = 64
DSA_HEADS = 8
DSA_DH = 128
IDX_HEADS = 8
IDX_DH = 64
TOPK_MAX = 256
Q_BLOCK = 64
REL_BUCKETS = 32
REL_MAX_DIST = 128
D_FF = 2816

IN_SIZES = (GLA_HEADS * GLA_DK, GLA_HEADS * GLA_DK, GLA_HEADS * GLA_DV, GLA_HEADS * GLA_DV, GLA_LOWRANK,
            DSA_HEADS * DSA_DH, DSA_HEADS * DSA_DH, DSA_HEADS * DSA_DH,
            IDX_HEADS * IDX_DH, IDX_DH, IDX_HEADS, D_MODEL, D_MODEL)
IN_WIDTH = sum(IN_SIZES)

kernel_name = 'gla_dsa_macaron_hybrid'


def rmsnorm(x, g):
    x32 = x.astype(jnp.float32)
    y = x32 * lax.rsqrt(jnp.mean(x32 * x32, axis=-1, keepdims=True) + EPS)
    return (y * g.astype(jnp.float32)).astype(x.dtype)


def swiglu(x, w_gate, w_up, w_down):
    return (jax.nn.silu(x @ w_gate) * (x @ w_up)) @ w_down


def rel_bucket(dist):
    n = jnp.maximum(dist, 0)
    max_exact = REL_BUCKETS // 2
    nf = jnp.maximum(n, max_exact).astype(jnp.float32)
    large = max_exact + (jnp.log(nf / max_exact) / math.log(REL_MAX_DIST / max_exact)
                         * (REL_BUCKETS - max_exact)).astype(jnp.int32)
    large = jnp.minimum(large, REL_BUCKETS - 1)
    return jnp.where(n < max_exact, n, large)


def split_in(z):
    idx = np.cumsum(np.array(IN_SIZES))[:-1].tolist()
    return jnp.split(z, idx, axis=-1)


def gla_mixer(q, k, v, r, lr, w_lr, b_lr, g_norm):
    B, T, _ = q.shape
    H, dk, dv, C = GLA_HEADS, GLA_DK, GLA_DV, GLA_CHUNK
    log_a = jax.nn.log_sigmoid((lr @ w_lr + b_lr).astype(jnp.float32)) / GLA_TAU
    pad = (-N_META) % C
    Tp = T + pad
    n = Tp // C
    def chunks(a, d):
        a = jnp.pad(a.astype(jnp.float32), ((0, 0), (pad, 0), (0, 0)))
        return a.reshape(B, n, C, H, d).transpose(1, 0, 3, 2, 4)
    qc = chunks(q, dk) * (dk ** -0.5)
    kc = chunks(k, dk)
    vc = chunks(v, dv)
    gc = chunks(log_a, dk)
    causal = jnp.tril(jnp.ones((C, C), dtype=bool))

    def step(S, inp):
        qi, ki, vi, gi = inp
        b = jnp.cumsum(gi, axis=2)
        diff = b[:, :, :, None, :] - b[:, :, None, :, :]
        decay = jnp.exp(jnp.where(causal[None, None, :, :, None], diff, -jnp.inf))
        A = jnp.einsum('bhtd,bhsd,bhtsd->bhts', qi, ki, decay)
        o = jnp.einsum('bhts,bhsv->bhtv', A, vi) + jnp.einsum('bhtd,bhdv->bhtv', qi * jnp.exp(b), S)
        b_last = b[:, :, -1:, :]
        S = jnp.exp(b_last[:, :, 0, :])[..., None] * S + jnp.einsum('bhsd,bhsv->bhdv', ki * jnp.exp(b_last - b), vi)
        return S, o

    S0 = jnp.zeros((B, H, dk, dv), jnp.float32)
    _, o = lax.scan(step, S0, (qc, kc, vc, gc))
    o = o.transpose(1, 0, 3, 2, 4).reshape(B, Tp, H, dv)[:, pad:].astype(v.dtype)
    o = rmsnorm(o, g_norm)
    return o.reshape(B, T, H * dv) * jax.nn.silu(r)


def dsa_mixer(q, k, v, iq, ik, iw, rel_bias):
    B, T, _ = q.shape
    H, dh, Hi, di, QB = DSA_HEADS, DSA_DH, IDX_HEADS, IDX_DH, Q_BLOCK
    L = T - N_META
    topk = min(TOPK_MAX, L // 4)
    q = q.reshape(B, T, H, dh) * (dh ** -0.5)
    k = k.reshape(B, T, H, dh)
    v = v.reshape(B, T, H, dh)
    iq = iq.reshape(B, T, Hi, di)
    iw = iw * ((Hi ** -0.5) * (di ** -0.5))
    n_blk = -(-T // QB)
    Tp = n_blk * QB
    def blocks(a):
        a = jnp.pad(a, ((0, 0), (0, Tp - T)) + ((0, 0),) * (a.ndim - 2))
        return jnp.moveaxis(a.reshape((B, n_blk, QB) + a.shape[2:]), 1, 0)
    key_pos = jnp.arange(T, dtype=jnp.int32)
    starts = jnp.arange(n_blk, dtype=jnp.int32) * QB

    def block(args):
        qb, iqb, iwb, start = args
        qpos = start + jnp.arange(QB, dtype=jnp.int32)
        s = jnp.einsum('bqhd,bkd->bqhk', iqb, ik)
        score = jnp.einsum('bqh,bqhk->bqk', iwb, jax.nn.relu(s)).astype(jnp.float32)
        admissible = key_pos[None, :] <= qpos[:, None]
        score = jnp.where(admissible[None], score, -jnp.inf)
        _, idx = lax.top_k(score, topk)
        kg = jax.vmap(lambda kk, ii: kk[ii])(k, idx)
        vg = jax.vmap(lambda vv, ii: vv[ii])(v, idx)
        logits = jnp.einsum('bqhd,bqkhd->bhqk', qb, kg).astype(jnp.float32)
        dist = qpos[None, :, None] - idx
        bias = rel_bias[rel_bucket(dist)].astype(jnp.float32)
        logits = logits + jnp.transpose(bias, (0, 3, 1, 2))
        valid = idx <= qpos[None, :, None]
        logits = jnp.where(valid[:, None], logits, -jnp.inf)
        p = jax.nn.softmax(logits, axis=-1).astype(v.dtype)
        return jnp.einsum('bhqk,bqkhd->bqhd', p, vg)

    out = lax.map(block, (blocks(q), blocks(iq), blocks(iw), starts))
    return jnp.moveaxis(out, 0, 1).reshape(B, Tp, H * dh)[:, :T]


def setup_inputs(seed: int = 0) -> dict:
    key = jax.random.key(seed)
    ks = jax.random.split(key, 24)
    f32 = jnp.float32
    def nrm(k_, shape, scale):
        return jax.random.normal(k_, shape, f32) * scale
    def gain(k_, shape):
        return 1.0 + 0.02 * jax.random.normal(k_, shape, f32)
    Dl = DEPTH
    return {
        'x': jax.random.normal(ks[0], (BATCH, SEQ, D_MODEL), f32),
        'meta_tokens': nrm(ks[1], (N_META, D_MODEL), 1.0),
        'norm_ffn1': gain(ks[2], (Dl, D_MODEL)),
        'ffn1_w_gate': nrm(ks[3], (Dl, D_MODEL, D_FF), D_MODEL ** -0.5),
        'ffn1_w_up': nrm(ks[4], (Dl, D_MODEL, D_FF), D_MODEL ** -0.5),
        'ffn1_w_down': nrm(ks[5], (Dl, D_FF, D_MODEL), D_FF ** -0.5),
        'norm_mix': gain(ks[6], (Dl, D_MODEL)),
        'w_in': nrm(ks[7], (Dl, D_MODEL, IN_WIDTH), D_MODEL ** -0.5),
        'gla_w_lr': nrm(ks[8], (Dl, GLA_LOWRANK, GLA_HEADS * GLA_DK), GLA_LOWRANK ** -0.5),
        'gla_b_lr': nrm(ks[9], (Dl, GLA_HEADS * GLA_DK), 0.1),
        'gla_norm': gain(ks[10], (Dl, GLA_DV)),
        'w_up_a': nrm(ks[11], (Dl, GLA_HEADS * GLA_DV, D_MODEL), (GLA_HEADS * GLA_DV) ** -0.5),
        'w_up_b': nrm(ks[12], (Dl, DSA_HEADS * DSA_DH, D_MODEL), (DSA_HEADS * DSA_DH) ** -0.5),
        'w_out': nrm(ks[13], (Dl, D_MODEL, D_MODEL), D_MODEL ** -0.5),
        'rel_bias': nrm(ks[14], (REL_BUCKETS, DSA_HEADS), 0.5),
        'norm_ffn2': gain(ks[15], (Dl, D_MODEL)),
        'ffn2_w_gate': nrm(ks[16], (Dl, D_MODEL, D_FF), D_MODEL ** -0.5),
        'ffn2_w_up': nrm(ks[17], (Dl, D_MODEL, D_FF), D_MODEL ** -0.5),
        'ffn2_w_down': nrm(ks[18], (Dl, D_FF, D_MODEL), D_FF ** -0.5),
        'norm_final': gain(ks[19], (D_MODEL,)),
    }


def reference(x, meta_tokens, norm_ffn1, ffn1_w_gate, ffn1_w_up, ffn1_w_down, norm_mix, w_in,
              gla_w_lr, gla_b_lr, gla_norm, w_up_a, w_up_b, w_out, rel_bias, norm_ffn2,
              ffn2_w_gate, ffn2_w_up, ffn2_w_down, norm_final):
    B = x.shape[0]
    meta = jnp.broadcast_to(meta_tokens[None].astype(x.dtype), (B, N_META, D_MODEL))
    h = jnp.concatenate([meta, x], axis=1)
    for l in range(DEPTH):
        h = h + 0.5 * swiglu(rmsnorm(h, norm_ffn1[l]), ffn1_w_gate[l], ffn1_w_up[l], ffn1_w_down[l])
        u = rmsnorm(h, norm_mix[l])
        (gq, gk, gv, gr, glr, dq, dk_, dv_, iq, ik, iw, ga, gb) = split_in(u @ w_in[l])
        y_a = gla_mixer(gq, gk, gv, gr, glr, gla_w_lr[l], gla_b_lr[l], gla_norm[l])
        y_b = dsa_mixer(dq, dk_, dv_, iq, ik, iw, rel_bias)
        merged = jax.nn.sigmoid(ga) * (y_a @ w_up_a[l]) + jax.nn.sigmoid(gb) * (y_b @ w_up_b[l])
        h = h + merged @ w_out[l]
        h = h + 0.5 * swiglu(rmsnorm(h, norm_ffn2[l]), ffn2_w_gate[l], ffn2_w_up[l], ffn2_w_down[l])
    h = rmsnorm(h, norm_final)
    return h[:, N_META:]
```

```cpp
#define MK_N_LAUNCHES 16
#include <hip/hip_runtime.h>
#include <cstdio>
#include <cstdint>
#include <cmath>

namespace pg8 {
#define PG8_LAS __attribute__((address_space(3)))
typedef unsigned short bf16_t;
typedef short bf16x8 __attribute__((ext_vector_type(8)));
typedef float f32x4 __attribute__((ext_vector_type(4)));
typedef unsigned u32x4 __attribute__((ext_vector_type(4)));
constexpr int BM = 256, BK = 64, HALF = 128, HTB = HALF * BK * 2  , STAGE_BYTES = 8 * HTB, NXCD = 8, WGM = 8;

__host__ __device__ __forceinline__ int lds_byte(int r, int c) { const int st = (r >> 4) * 2 + (c >> 5), rr = r & 15, cc = c & 31, ob = rr * 64 + cc * 2; return st * 1024 + (ob ^ (((ob >> 9) & 1) << 5)); }
__host__ __device__ __forceinline__ void stage_rc(int b, int& R, int& C) { const int st = b / 1024, sb = b % 1024, swz = sb ^ (((sb >> 9) & 1) << 5); R = (st >> 1) * 16 + swz / 64; C = (st & 1) * 32 + (swz % 64) / 2; }
__host__ __device__ __forceinline__ int perm32(int rho) { const int n = rho >> 4, i = rho & 15; return 8 * (i >> 2) + 4 * n + (i & 3); }

struct Unit { int pm, pn, z; };
struct Gemm { const bf16_t* A; const bf16_t* Bt; int M, N, K; const bf16_t* A2; const bf16_t* Bt2; };

struct StaticOrder {
    int nM, nN, nwg, G, c;
    __host__ __device__ void init(int M, int N, int G_, int c_) { nM = M / BM; nN = N / BM; nwg = nM * nN; G = G_; c = c_; }
    __host__ __device__ bool next(int i, Unit& u) const {
        const long L = (long)i * G + c; if (L >= nwg) return false;
        int wgid = (int)L; { const int q = nwg / NXCD, r = nwg % NXCD, xcd = wgid % NXCD, off = wgid / NXCD; wgid = (xcd < r ? xcd * (q + 1) : r * (q + 1) + (xcd - r) * q) + off; }
        const int nig = WGM * nN, gid = wgid / nig, fm = gid * WGM, gsz = (nM - fm) < WGM ? (nM - fm) : WGM;
        u.pm = fm + ((wgid % nig) % gsz); u.pn = (wgid % nig) / gsz; u.z = 0; return true;
    }
    __device__ __forceinline__ void a_ready(const Unit&) const {}
    __device__ __forceinline__ void done(const Unit&) const {}
};


struct PairOrder {
    StaticOrder so;
    __host__ __device__ void init(int M, int N, int G_, int c_) { so.init(M, N, G_, c_); }
    __host__ __device__ bool next(int i, Unit& u) const { if (!so.next(i >> 1, u)) return false; u.z = i & 1; return true; }
    __device__ __forceinline__ void a_ready(const Unit&) const {}
    __device__ __forceinline__ void done(const Unit&) const {}
};

__device__ __forceinline__ unsigned f2bf_(float f) { unsigned u = __builtin_bit_cast(unsigned, f); return (u + 0x7fffu + ((u >> 16) & 1u)) >> 16; }
__device__ __forceinline__ unsigned pk2_(float lo, float hi) { return f2bf_(lo) | (f2bf_(hi) << 16); }
__device__ __forceinline__ u32x4 pack8(const f32x4 a, const f32x4 b) { u32x4 w; w.x = pk2_(a[0], a[1]); w.y = pk2_(a[2], a[3]); w.z = pk2_(b[0], b[1]); w.w = pk2_(b[2], b[3]); return w; }
__device__ __forceinline__ float silu_f(float x) { return x * __builtin_amdgcn_rcpf(1.f + __builtin_amdgcn_exp2f(-1.4426950408889634f * x)); }
__device__ __forceinline__ float sigm_f(float x) { return __builtin_amdgcn_rcpf(1.f + __builtin_amdgcn_exp2f(-1.4426950408889634f * x)); }
__device__ __forceinline__ f32x4 silu4(f32x4 v) { return (f32x4){silu_f(v[0]), silu_f(v[1]), silu_f(v[2]), silu_f(v[3])}; }
__device__ __forceinline__ f32x4 sigm4(f32x4 v) { return (f32x4){sigm_f(v[0]), sigm_f(v[1]), sigm_f(v[2]), sigm_f(v[3])}; }
constexpr float RMS_EPS = 1e-6f;
__device__ __forceinline__ float rstd_row(const float* ssq, int row) {
    const f32x4* p = (const f32x4*)(ssq + (size_t)row * 16); const f32x4 a = p[0], b = p[1], c = p[2], d = p[3];
    const float s = ((a[0] + a[1]) + (a[2] + a[3])) + ((b[0] + b[1]) + (b[2] + b[3])) + ((c[0] + c[1]) + (c[2] + c[3])) + ((d[0] + d[1]) + (d[2] + d[3]));
    return __builtin_amdgcn_rsqf(s * (1.0f / 1024.0f) + RMS_EPS);
}

struct EpiSwiglu {
    static constexpr bool PERM = true, AFTER_DRAIN = false;
    bf16_t* H; int ldh; const float* ssq;
    __device__ __forceinline__ bool keep(const Unit&) const { return false; }
    __device__ __forceinline__ void operator()(f32x4 (&acc)[2][2][4][2], const Unit& u, int wr, int wc, int fr, int fq) const {
        const int row0 = u.pm * BM + wr * 64 + fr, col0 = u.pn * HALF + wc * 32 + 8 * fq;
#pragma unroll
        for (int ai = 0; ai < 2; ++ai)
#pragma unroll
            for (int m = 0; m < 4; ++m) {
                const int row = row0 + ai * HALF + m * 16;
                const float rs = ssq ? rstd_row(ssq, row) : 1.f;
                const f32x4 g0 = acc[ai][0][m][0] * rs, g1 = acc[ai][0][m][1] * rs, u0 = acc[ai][1][m][0] * rs, u1 = acc[ai][1][m][1] * rs;
                *(u32x4*)(H + (size_t)row * ldh + col0) = pack8(silu4(g0) * u0, silu4(g1) * u1);
            }
    }
};

struct EpiResid {
    static constexpr bool PERM = true, AFTER_DRAIN = false;
    const float* base; float* out; const float* mbase; float* mout; float alpha; bf16_t* xn; const float* gain; float* ssq; int nreal;
    __device__ __forceinline__ bool keep(const Unit&) const { return false; }
    __device__ __forceinline__ void operator()(f32x4 (&acc)[2][2][4][2], const Unit& u, int wr, int wc, int fr, int fq) const {
        const int row0 = u.pm * BM + wr * 64 + fr, colb = u.pn * BM + wc * 32 + 8 * fq;
#pragma unroll
        for (int ai = 0; ai < 2; ++ai)
#pragma unroll
            for (int m = 0; m < 4; ++m) {
                const int row = row0 + ai * HALF + m * 16;
                const float* bp; float* op;
                if (row < nreal) { bp = base + (size_t)row * 1024; op = out + (size_t)row * 1024; }
                else if (mbase && row < nreal + 16) { bp = mbase + (size_t)(row - nreal) * 1024; op = mout + (size_t)(row - nreal) * 1024; }
                else continue;
                float ss = 0.f;
#pragma unroll
                for (int bj = 0; bj < 2; ++bj) {
                    const int col = colb + bj * HALF;
                    const f32x4 b0 = *(const f32x4*)(bp + col), b1 = *(const f32x4*)(bp + col + 4);
                    const f32x4 h0 = b0 + acc[ai][bj][m][0] * alpha, h1 = b1 + acc[ai][bj][m][1] * alpha;
                    *(f32x4*)(op + col) = h0; *(f32x4*)(op + col + 4) = h1;
                    ss += (h0[0] * h0[0] + h0[1] * h0[1]) + (h0[2] * h0[2] + h0[3] * h0[3]) + (h1[0] * h1[0] + h1[1] * h1[1]) + (h1[2] * h1[2] + h1[3] * h1[3]);
                    if (xn) { const f32x4 g0 = *(const f32x4*)(gain + col), g1 = *(const f32x4*)(gain + col + 4);
                        *(u32x4*)(xn + (size_t)row * 1024 + col) = pack8(h0 * g0, h1 * g1); }
                }
                ss += __shfl_xor(ss, 16); ss += __shfl_xor(ss, 32);
                if (fq == 0 && ssq) ssq[(size_t)row * 16 + u.pn * 4 + wc] = ss;
            }
    }
};

struct EpiWin {
    static constexpr bool PERM = true, AFTER_DRAIN = false;
    const float* ssq; int ct0;
    bf16_t *GQ, *GK, *GV, *GR, *IQ, *DQ, *DK, *DV, *GA, *GB, *IK; float* GLR; float* IW;
    __device__ __forceinline__ bool keep(const Unit&) const { return false; }
    __device__ __forceinline__ static size_t kvrow(int row) { return (size_t)(row >> 13) * 8320 + 16 + (row & 8191); }
    __device__ __forceinline__ void operator()(f32x4 (&acc)[2][2][4][2], const Unit& u, int wr, int wc, int fr, int fq) const {
        const int ct = ct0 + u.pn;
        bf16_t* P; int ld, cb, mode; float sc = 1.f;
        if (ct < 2)       { P = GQ; ld = 512;  cb = ct * 256;        mode = 0; sc = 0.08838834764831845f; }
        else if (ct < 4)  { P = GK; ld = 512;  cb = (ct - 2) * 256;  mode = 1; }
        else if (ct < 8)  { P = GV; ld = 1024; cb = (ct - 4) * 256;  mode = 1; }
        else if (ct < 12) { P = GR; ld = 1024; cb = (ct - 8) * 256;  mode = 2; }
        else if (ct < 14) { P = IQ; ld = 512;  cb = (ct - 12) * 256; mode = 0; }
        else if (ct == 14){ P = IK; ld = 64;   cb = 0;               mode = 5; }
        else if (ct < 19) { P = DQ; ld = 1024; cb = (ct - 15) * 256; mode = 0; sc = 0.08838834764831845f * 1.4426950408889634f; }
        else if (ct < 23) { P = DK; ld = 1024; cb = (ct - 19) * 256; mode = 4; }
        else if (ct < 27) { P = DV; ld = 1024; cb = (ct - 23) * 256; mode = 4; }
        else if (ct < 31) { P = GA; ld = 1024; cb = (ct - 27) * 256; mode = 3; }
        else              { P = GB; ld = 1024; cb = (ct - 31) * 256; mode = 3; }
        const int row0 = u.pm * BM + wr * 64 + fr, cl = wc * 32 + 8 * fq;
#pragma unroll
        for (int ai = 0; ai < 2; ++ai)
#pragma unroll
            for (int m = 0; m < 4; ++m) {
                const int row = row0 + ai * HALF + m * 16;
                if (row >= 16400) continue;
                const bool meta = row >= 16384;
                if (meta && (mode == 0 || mode == 2 || mode == 3)) continue;
                const float rs = rstd_row(ssq, row) * sc;
#pragma unroll
                for (int bj = 0; bj < 2; ++bj) {
                    f32x4 v0 = acc[ai][bj][m][0] * rs, v1 = acc[ai][bj][m][1] * rs;
                    const int c = bj * HALF + cl;
                    if (mode == 5) {
                        if (bj == 1 || c >= 88) continue;
                        if (c < 16) { float* g = GLR + (size_t)row * 16 + c; *(f32x4*)g = v0; *(f32x4*)(g + 4) = v1; }
                        else if (c < 80) { const u32x4 w = pack8(v0, v1);
                            if (!meta) *(u32x4*)(IK + kvrow(row) * 64 + (c - 16)) = w;
                            else { *(u32x4*)(IK + (size_t)(row - 16384) * 64 + (c - 16)) = w; *(u32x4*)(IK + (size_t)(8320 + row - 16384) * 64 + (c - 16)) = w; } }
                        else if (!meta) { const float s = 0.04419417382415922f; float* g = IW + (size_t)row * 8; *(f32x4*)g = v0 * s; *(f32x4*)(g + 4) = v1 * s; }
                        continue;
                    }
                    if (mode == 2) { v0 = silu4(v0); v1 = silu4(v1); }
                    if (mode == 3) { v0 = sigm4(v0); v1 = sigm4(v1); }
                    const u32x4 w = pack8(v0, v1);
                    if (mode == 4) {
                        if (!meta) *(u32x4*)(P + kvrow(row) * ld + cb + c) = w;
                        else { *(u32x4*)(P + (size_t)(row - 16384) * ld + cb + c) = w; *(u32x4*)(P + (size_t)(8320 + row - 16384) * ld + cb + c) = w; }
                    } else *(u32x4*)(P + (size_t)row * ld + cb + c) = w;
                }
            }
    }
};

struct EpiMerge {
    static constexpr bool PERM = true, AFTER_DRAIN = false;
    const bf16_t* GA; const bf16_t* GB; bf16_t* O;
    __device__ __forceinline__ bool keep(const Unit& u) const { return u.z == 0; }
    __device__ __forceinline__ static float bf(unsigned short x) { return __builtin_bit_cast(float, (unsigned)x << 16); }
    __device__ __forceinline__ void operator()(f32x4 (&acc)[2][2][4][2], const Unit& u, int wr, int wc, int fr, int fq) const {
        const int row0 = u.pm * BM + wr * 64 + fr, colb = u.pn * BM + wc * 32 + 8 * fq;
#pragma unroll
        for (int ai = 0; ai < 2; ++ai)
#pragma unroll
            for (int m = 0; m < 4; ++m) {
                const int row = row0 + ai * HALF + m * 16;
#pragma unroll
                for (int bj = 0; bj < 2; ++bj) {
                    const size_t off = (size_t)row * 1024 + colb + bj * HALF;
                    const bf16x8 sb = *(const bf16x8*)(GB + off);
                    if (u.z == 0) {
                        const bf16x8 sa = *(const bf16x8*)(GA + off);
#pragma unroll
                        for (int e = 0; e < 4; ++e) {
                            acc[ai][bj][m][0][e] *= bf((unsigned short)sa[e]) * __builtin_amdgcn_rcpf(bf((unsigned short)sb[e]));
                            acc[ai][bj][m][1][e] *= bf((unsigned short)sa[4 + e]) * __builtin_amdgcn_rcpf(bf((unsigned short)sb[4 + e]));
                        }
                    } else {
                        f32x4 v0, v1;
#pragma unroll
                        for (int e = 0; e < 4; ++e) { v0[e] = acc[ai][bj][m][0][e] * bf((unsigned short)sb[e]); v1[e] = acc[ai][bj][m][1][e] * bf((unsigned short)sb[4 + e]); }
                        *(u32x4*)(O + off) = pack8(v0, v1);
                    }
                }
            }
    }
};

template <class Epi, class Sched, bool ALIGN_EPI = false, bool SP2 = false>
__device__ __forceinline__ void gemm_phase(PG8_LAS unsigned char* lds, const Gemm g, const Sched& S, const Epi& E) {
    const int tid = threadIdx.x, wid = __builtin_amdgcn_readfirstlane(tid >> 6), lane = tid & 63, wr = wid >> 2, wc = wid & 3, fr = lane & 15, fq = lane >> 4;
    const int K = g.K, nt = K / BK;
    unsigned voffA[2], voffB[2];
#pragma unroll
    for (int i = 0; i < 2; ++i) { int R, C; stage_rc(tid * 16 + i * 8192, R, C); const int Rb = Epi::PERM ? ((R & ~31) + perm32(R & 31)) : R;
        voffA[i] = (unsigned)(R * K + C) * 2u; voffB[i] = (unsigned)(Rb * K + C) * 2u; }
    const size_t kstep = (size_t)(BK * 2);
    const size_t hstep = (size_t)HALF * K * 2;
    const size_t tstep = 2 * hstep;
    const unsigned ldsw = (unsigned)wid * 1024u;
    const int aoff = lds_byte(wr * 64 + fr, fq * 8), boff = lds_byte(wc * 32 + fr, fq * 8);
#define PG8_SA(b, h) (((b) * 2 + (h)) * HTB)
#define PG8_SB(b, h) ((4 + (b) * 2 + (h)) * HTB)
#define PG8_STAGE(bufoff, gbase, voff) do { _Pragma("unroll") for (int _i = 0; _i < 2; ++_i) \
        __builtin_amdgcn_global_load_lds((const unsigned*)((const char*)(gbase) + (voff)[_i]), (PG8_LAS unsigned*)(lds + (bufoff) + ldsw + _i * 8192), 16, 0, 0); } while (0)
#define PG8_LDA(dst, b, h) do { _Pragma("unroll") for (int m = 0; m < 4; ++m) _Pragma("unroll") for (int k = 0; k < 2; ++k) dst[m][k] = *(const PG8_LAS bf16x8*)(lds + PG8_SA(b, h) + aoff + m * 2048 + k * 1024); } while (0)
#define PG8_LDB(dst, b, h) do { _Pragma("unroll") for (int n = 0; n < 2; ++n) _Pragma("unroll") for (int k = 0; k < 2; ++k) dst[n][k] = *(const PG8_LAS bf16x8*)(lds + PG8_SB(b, h) + boff + n * 2048 + k * 1024); } while (0)
#define PG8_MMA(ai, bj, At, Bt) do { __builtin_amdgcn_s_setprio(1); _Pragma("unroll") for (int m = 0; m < 4; ++m) _Pragma("unroll") for (int n = 0; n < 2; ++n) _Pragma("unroll") for (int k = 0; k < 2; ++k) \
        acc[ai][bj][m][n] = __builtin_amdgcn_mfma_f32_16x16x32_bf16(Bt[n][k], At[m][k], acc[ai][bj][m][n], 0, 0, 0); __builtin_amdgcn_s_setprio(0); } while (0)
#define PG8_WAIT_V(n) asm volatile("s_waitcnt vmcnt(" #n ")" ::: "memory")
#define PG8_WAIT_L(n) asm volatile("s_waitcnt lgkmcnt(" #n ")" ::: "memory")
#define PG8_BAR __builtin_amdgcn_s_barrier()
#define PG8_SCHED __builtin_amdgcn_sched_barrier(0)
    Unit cur, nxt; int ui = 0;
    if (!S.next(0, cur)) return;
    f32x4 acc[2][2][4][2];
#pragma unroll
    for (int a = 0; a < 2; ++a)
#pragma unroll
        for (int b = 0; b < 2; ++b)
#pragma unroll
            for (int m = 0; m < 4; ++m)
#pragma unroll
                for (int n = 0; n < 2; ++n) acc[a][b][m][n] = (f32x4){0.f, 0.f, 0.f, 0.f};
    bf16x8 At[4][2], B0[2][2], B1[2][2];
    const char* cA = (const char*)(cur.z ? g.A2 : g.A) + (size_t)cur.pm * tstep; const char* cB = (const char*)(cur.z ? g.Bt2 : g.Bt) + (size_t)cur.pn * tstep;
    S.a_ready(cur);
    if constexpr (SP2) {
        PG8_STAGE(PG8_SB(0, 0), cB, voffB); PG8_STAGE(PG8_SB(0, 1), cB + hstep, voffB); PG8_STAGE(PG8_SA(0, 0), cA, voffA); PG8_STAGE(PG8_SA(0, 1), cA + hstep, voffA);
        if (wr == 1) PG8_BAR;
        PG8_WAIT_V(2); PG8_BAR;
        PG8_STAGE(PG8_SB(1, 0), cB + kstep, voffB); PG8_STAGE(PG8_SA(1, 0), cA + kstep, voffA); PG8_STAGE(PG8_SB(1, 1), cB + hstep + kstep, voffB);
        PG8_WAIT_V(6); PG8_BAR;
    } else {
        PG8_STAGE(PG8_SB(0, 0), cB, voffB); PG8_STAGE(PG8_SA(0, 0), cA, voffA); PG8_STAGE(PG8_SB(0, 1), cB + hstep, voffB); PG8_STAGE(PG8_SA(0, 1), cA + hstep, voffA);
        if (wr == 1) PG8_BAR;
        PG8_WAIT_V(4); PG8_BAR;
        PG8_STAGE(PG8_SB(1, 0), cB + kstep, voffB); PG8_STAGE(PG8_SA(1, 0), cA + kstep, voffA); PG8_STAGE(PG8_SB(1, 1), cB + hstep + kstep, voffB);
        PG8_WAIT_V(6); PG8_BAR;
    }
    for (;;) {
        const bool has_next = S.next(ui + 1, nxt);
        const char* nA = has_next ? (const char*)(nxt.z ? g.A2 : g.A) + (size_t)nxt.pm * tstep : cA; const char* nB = has_next ? (const char*)(nxt.z ? g.Bt2 : g.Bt) + (size_t)nxt.pn * tstep : cB;
        for (int t = 0; t < nt; t += 2) {
            const bool last = (t == nt - 2);
            const char* a1 = cA + (size_t)(t + 1) * kstep;
            const char* a2 = last ? nA : cA + (size_t)(t + 2) * kstep; const char* b2 = last ? nB : cB + (size_t)(t + 2) * kstep;
            const char* a3 = a2 + kstep; const char* b3 = b2 + kstep;
            if (last && has_next) S.a_ready(nxt);
            if constexpr (SP2) {
            PG8_LDB(B0, 0, 0); PG8_LDB(B1, 0, 1); PG8_SCHED; PG8_LDA(At, 0, 0); PG8_STAGE(PG8_SA(1, 1), a1 + hstep, voffA);
            PG8_WAIT_V(8); PG8_WAIT_L(0); PG8_BAR; PG8_MMA(0, 0, At, B0); PG8_MMA(0, 1, At, B1); PG8_BAR; PG8_SCHED;
            PG8_LDA(At, 0, 1); PG8_STAGE(PG8_SB(0, 0), b2, voffB); PG8_STAGE(PG8_SB(0, 1), b2 + hstep, voffB); PG8_STAGE(PG8_SA(0, 0), a2, voffA);
            PG8_WAIT_V(8); PG8_WAIT_L(0); PG8_BAR; PG8_MMA(1, 0, At, B0); PG8_MMA(1, 1, At, B1); PG8_BAR; PG8_SCHED;
            PG8_LDB(B0, 1, 0); PG8_LDB(B1, 1, 1); PG8_SCHED; PG8_LDA(At, 1, 0); PG8_STAGE(PG8_SA(0, 1), a2 + hstep, voffA);
            PG8_WAIT_V(8); PG8_WAIT_L(0); PG8_BAR; PG8_MMA(0, 0, At, B0); PG8_MMA(0, 1, At, B1); PG8_BAR; PG8_SCHED;
            PG8_LDA(At, 1, 1); PG8_STAGE(PG8_SB(1, 0), b3, voffB); PG8_STAGE(PG8_SB(1, 1), b3 + hstep, voffB); PG8_STAGE(PG8_SA(1, 0), a3, voffA);
            PG8_WAIT_V(8); PG8_WAIT_L(0); PG8_BAR; PG8_MMA(1, 0, At, B0); PG8_MMA(1, 1, At, B1); PG8_BAR; PG8_SCHED;
            } else {
            PG8_LDB(B0, 0, 0); PG8_SCHED; PG8_LDA(At, 0, 0); PG8_STAGE(PG8_SA(1, 1), a1 + hstep, voffA);
            PG8_WAIT_L(8); PG8_BAR; PG8_WAIT_L(0); PG8_MMA(0, 0, At, B0); PG8_BAR; PG8_SCHED;
            PG8_LDB(B1, 0, 1); PG8_STAGE(PG8_SB(0, 0), b2, voffB);
            PG8_BAR; PG8_WAIT_L(0); PG8_MMA(0, 1, At, B1); PG8_BAR;
            PG8_LDA(At, 0, 1); PG8_STAGE(PG8_SA(0, 0), a2, voffA);
            PG8_BAR; PG8_WAIT_L(0); PG8_MMA(1, 0, At, B0); PG8_BAR; PG8_SCHED;
            PG8_STAGE(PG8_SB(0, 1), b2 + hstep, voffB);
            PG8_WAIT_V(6); PG8_BAR; PG8_MMA(1, 1, At, B1); PG8_BAR;
            PG8_LDB(B0, 1, 0); PG8_SCHED; PG8_LDA(At, 1, 0); PG8_STAGE(PG8_SA(0, 1), a2 + hstep, voffA);
            PG8_WAIT_L(8); PG8_BAR; PG8_WAIT_L(0); PG8_MMA(0, 0, At, B0); PG8_BAR; PG8_SCHED;
            PG8_LDB(B1, 1, 1); PG8_STAGE(PG8_SB(1, 0), b3, voffB);
            PG8_BAR; PG8_WAIT_L(0); PG8_MMA(0, 1, At, B1); PG8_BAR;
            PG8_LDA(At, 1, 1); PG8_STAGE(PG8_SA(1, 0), a3, voffA);
            PG8_BAR; PG8_WAIT_L(0); PG8_MMA(1, 0, At, B0); PG8_BAR; PG8_SCHED;
            PG8_STAGE(PG8_SB(1, 1), b3 + hstep, voffB);
            PG8_WAIT_V(6); PG8_BAR; PG8_MMA(1, 1, At, B1); PG8_BAR;
            }
        }
        if constexpr (ALIGN_EPI) { if (wr == 0) PG8_BAR; }
        if constexpr (!Epi::AFTER_DRAIN) { E(acc, cur, wr, wc, fr, fq); S.done(cur); }
        if (!has_next) break;
        if (!E.keep(cur)) {
#pragma unroll
        for (int a = 0; a < 2; ++a)
#pragma unroll
            for (int b = 0; b < 2; ++b)
#pragma unroll
                for (int m = 0; m < 4; ++m)
#pragma unroll
                    for (int n = 0; n < 2; ++n) acc[a][b][m][n] = (f32x4){0.f, 0.f, 0.f, 0.f};
        }
        cur = nxt; cA = nA; cB = nB; ++ui;
        if constexpr (ALIGN_EPI) { if (wr == 1) PG8_BAR; }
    }
    PG8_WAIT_V(0);
    if constexpr (!ALIGN_EPI) { if (wr == 0) PG8_BAR; }
    PG8_BAR;
    if constexpr (Epi::AFTER_DRAIN) { E.fused(acc, cur, wr, wc, fr, fq, lds, wid, lane); S.done(cur); }
#undef PG8_SA
#undef PG8_SB
#undef PG8_STAGE
#undef PG8_LDA
#undef PG8_LDB
#undef PG8_MMA
#undef PG8_WAIT_V
#undef PG8_WAIT_L
#undef PG8_BAR
#undef PG8_SCHED
}
}

#define GAS __attribute__((address_space(1)))
#define LAS __attribute__((address_space(3)))
typedef unsigned short bf16;
typedef unsigned v4u __attribute__((ext_vector_type(4)));
typedef float f32x4 __attribute__((ext_vector_type(4)));
typedef short bf16x8 __attribute__((ext_vector_type(8)));
typedef GAS unsigned gu32;
typedef GAS unsigned long long gu64;
#define RLX_AGENT __ATOMIC_RELAXED, __HIP_MEMORY_SCOPE_AGENT
#define LDS_WAIT() asm volatile("s_waitcnt lgkmcnt(0)" ::: "memory")
#define VM_WAIT() asm volatile("s_waitcnt vmcnt(0)" ::: "memory")
__device__ __forceinline__ unsigned long long rt() { return __builtin_amdgcn_s_memrealtime(); }
__device__ __forceinline__ unsigned f2bf(float f) { unsigned u = __builtin_bit_cast(unsigned, f); return (u + 0x7fffu + ((u >> 16) & 1u)) >> 16; }
__device__ __forceinline__ unsigned pk2(float lo, float hi) { return f2bf(lo) | (f2bf(hi) << 16); }

#define XB_TMO      128
#define XB_XCNT(j)  (256  + 64 * (j))
#define XB_XSUB(j)  (1280 + 64 * (j))
#define XB_XGEN(j)  (2304 + 64 * (j))
#define XB_TOP      3328
#define XB_TOPGEN   3392
#define XCD_BAR_WORDS 3456
#define XB_SPIN_CAP (1u << 25)

__device__ __forceinline__ unsigned xb_ld(unsigned* p)              { return __hip_atomic_load(p, __ATOMIC_RELAXED, __HIP_MEMORY_SCOPE_AGENT); }
__device__ __forceinline__ unsigned xb_add(unsigned* p, unsigned v) { return __hip_atomic_fetch_add(p, v, __ATOMIC_RELAXED, __HIP_MEMORY_SCOPE_AGENT); }
__device__ __forceinline__ unsigned xb_xcc_id() { return (unsigned)__builtin_amdgcn_s_getreg((3 << 11) | 20) & 0xFu; }
#define XB_SPIN(cond, bar) do { unsigned _sp = 0; while (cond) { __builtin_amdgcn_s_sleep(1); \
    if ((++_sp & 255u) == 0u) { if (xb_ld(&(bar)[XB_TMO])) break; if (_sp > XB_SPIN_CAP) { atomicAdd(&(bar)[XB_TMO], 1u); break; } } } } while (0)

struct XcdBarrier {
    unsigned* bar; unsigned x;
    volatile LAS unsigned* st;
};

__device__ __forceinline__ XcdBarrier xcd_barrier_post(unsigned* bar, volatile LAS unsigned* st) {
    XcdBarrier b; b.bar = bar; b.x = xb_xcc_id(); b.st = st;
    if (threadIdx.x == 0) (void)xb_add(&bar[XB_XCNT(b.x)], 1u);
    return b;
}
__device__ __forceinline__ void xcd_barrier_complete(unsigned* bar, unsigned x, unsigned& nloc, unsigned& nx) {
    const unsigned G = gridDim.x * gridDim.y * gridDim.z;
    unsigned sum, cnt, mine, sp = 0u;
    for (;;) {
        sum = 0u; cnt = 0u; mine = 0u;
#pragma unroll
        for (unsigned j = 0; j < 16; ++j) { const unsigned c = xb_ld(&bar[XB_XCNT(j)]); sum += c; cnt += (c > 0u) ? 1u : 0u; mine = (j == x) ? c : mine; }
        if (sum == G) break;
        __builtin_amdgcn_s_sleep(1);
        if ((++sp & 255u) == 0u) { if (xb_ld(&bar[XB_TMO])) break; if (sp > XB_SPIN_CAP) { atomicAdd(&bar[XB_TMO], 1u); break; } }
    }
    nloc = mine > 0u ? mine : 1u; nx = cnt > 0u ? cnt : 1u;
}

__device__ __forceinline__ void xcd_barrier(const XcdBarrier& b) {
    asm volatile("s_waitcnt vmcnt(0)" ::: "memory");
    __syncthreads();
    if (threadIdx.x == 0) {
        unsigned* bar = b.bar;
        __builtin_amdgcn_s_waitcnt(0);
        unsigned nloc = b.st[0], nx = b.st[1];
        if (nloc == 0u) { xcd_barrier_complete(bar, b.x, nloc, nx); b.st[0] = nloc; b.st[1] = nx; }
        const unsigned old = xb_add(&bar[XB_XSUB(b.x)], 1u);
        const unsigned gen = old / nloc;
        if (old + 1u == (gen + 1u) * nloc) {
            __builtin_amdgcn_fence(__ATOMIC_RELEASE, "agent");
            asm volatile("s_waitcnt vmcnt(0)" ::: "memory");
            const unsigned og = xb_add(&bar[XB_TOP], 1u);
            const unsigned tg = og / nx;
            if (og + 1u == (tg + 1u) * nx) xb_add(&bar[XB_TOPGEN], 1u);
            else XB_SPIN(xb_ld(&bar[XB_TOPGEN]) == tg, bar);
            __builtin_amdgcn_fence(__ATOMIC_ACQUIRE, "agent");
            xb_add(&bar[XB_XGEN(b.x)], 1u);
            asm volatile("s_waitcnt vmcnt(0)" ::: "memory");
        } else {
            XB_SPIN(xb_ld(&bar[XB_XGEN(b.x)]) == gen, bar);
            __builtin_amdgcn_fence(__ATOMIC_ACQUIRE, "agent");
            asm volatile("s_waitcnt vmcnt(0)" ::: "memory");
        }
    }
    __syncthreads();
}


constexpr int NWAVES = 8;
constexpr int DM = 1024, DFF = 2816, NREAL = 16384, NROWS = 16640  , TSEQ = 8192, NMETA = 16, KVR = 8320  ;
constexpr int NCT_WIN = 35;
constexpr int MASKW = 260;
constexpr size_t MiB = 1u << 20, QMiB = 1u << 18;
constexpr size_t WS_CTL = 0, CTL_ZERO_BYTES = 1 * MiB;
constexpr size_t WS_SSQA = 4 * QMiB, WS_SSQB = 9 * QMiB, WS_SSQC = 14 * QMiB, WS_METAH = 19 * QMiB, WS_BIAST = 19 * QMiB + 65536, WS_GLR = 20 * QMiB, WS_IW = 25 * QMiB, WS_DBUF = 27 * QMiB;
constexpr size_t WS_W1GU = 8 * MiB, WS_W1D = 19 * MiB, WS_WIN = 98 * QMiB, WS_WA = 42 * MiB, WS_WB = 44 * MiB, WS_WO = 46 * MiB, WS_W2GU = 48 * MiB, WS_W2D = 59 * MiB;
constexpr size_t WS_MASK = 8 * MiB;
constexpr size_t WS_XN = 65 * MiB;
constexpr size_t WS_HB = 98 * MiB;
constexpr size_t WS_GQ = 98 * MiB, WS_GK = 114 * MiB, WS_GV = 521 * QMiB, WS_GR = 651 * QMiB, WS_LBUF = 195 * MiB, WS_TT = 212 * MiB, WS_IKB = 227 * MiB, WS_IQ = 230 * MiB;
constexpr size_t WS_DQ = 98 * MiB, WS_DKB = 130 * MiB, WS_DVB = 212 * MiB;
constexpr size_t WS_GA = 130 * MiB, WS_GB = 212 * MiB;
constexpr size_t WS_A3 = 98 * MiB, WS_HB2 = 130 * MiB;
constexpr size_t WS_END = 256 * MiB;
static_assert(WS_WIN + (size_t)NCT_WIN * 256 * 1024 * 2 <= WS_WA && WS_W2D + (size_t)1024 * DFF * 2 <= WS_XN && WS_XN + (size_t)NROWS * 1024 * 2 <= WS_HB, "ws map 1");
static_assert(WS_HB + (size_t)NROWS * DFF * 2 <= WS_END && WS_GR + (size_t)NREAL * 1024 * 2 <= WS_LBUF && WS_GV + (size_t)NROWS * 1024 * 2 <= WS_GR && WS_GK + (size_t)NROWS * 512 * 2 <= WS_GV, "ws map 2");
static_assert(WS_LBUF + (size_t)132 * 131072 <= WS_TT && WS_TT + (size_t)128 * 65536 <= WS_IKB && WS_IKB + (size_t)2 * KVR * 64 * 2 <= WS_IQ && WS_IQ + (size_t)NREAL * 512 * 2 <= WS_END, "ws map 3");
static_assert(WS_DKB + (size_t)2 * KVR * 1024 * 2 <= WS_GR && WS_DVB + (size_t)2 * KVR * 1024 * 2 <= WS_END && WS_MASK + (size_t)NREAL * MASKW * 4 <= WS_WIN && WS_HB2 + (size_t)NREAL * DFF * 2 <= WS_END, "ws map 4");
static_assert(WS_SSQA + (size_t)NROWS * 64 <= WS_SSQB && WS_SSQB + (size_t)NROWS * 64 <= WS_SSQC && WS_SSQC + (size_t)NROWS * 64 <= WS_METAH && WS_GLR + (size_t)NROWS * 64 <= WS_IW && WS_IW + (size_t)NREAL * 32 <= WS_DBUF && WS_DBUF + 132 * 512 <= WS_W1GU, "ws map 5");
constexpr int CW_TMO = 0, CW_CODE = 1, CW_BAR = 4096, CW_QUEUE = 16384;

constexpr int RING_OFF = 0, RING_BYTES = 131072;
constexpr int LDSCTL_OFF = RING_BYTES, MISC_OFF = LDSCTL_OFF + 320;
constexpr int LDS_BYTES = 147456;

struct Frame {
    LAS unsigned char* lds;
    volatile LAS unsigned* MISC;
    gu32* ctl;
    int tid, lane, wave, vcu, G;
    unsigned char* ws;
    const float *x, *meta, *n1, *w1g, *w1u, *w1d, *nm, *win, *wlr, *blr, *gn, *wa, *wb, *wo, *rb, *n2, *w2g, *w2u, *w2d, *nf;
    float* out;
};
__device__ __forceinline__ float wave_sum(float v) {
#pragma unroll
    for (int o = 1; o < 64; o <<= 1) v += __shfl_xor(v, o);
    return v;
}
__device__ __forceinline__ float bf2f(unsigned short x) { return __builtin_bit_cast(float, (unsigned)x << 16); }


template <class F>
__device__ __forceinline__ void p0_transpose_item(const float* W, int Nsrc, int K, bf16* WT, int nblk, LAS float* scr, int item, int lane, F srccol) {
    const int kb = item / nblk, nb = item % nblk, k0 = 64 * kb, n0 = 32 * nb;
    const int sc = srccol(n0 + (lane & 31));
#pragma unroll 8
    for (int i = 0; i < 32; ++i) { const int kk = 2 * i + (lane >> 5); scr[kk * 33 + (lane & 31)] = sc >= 0 ? W[(size_t)(k0 + kk) * Nsrc + sc] : 0.f; }
    LDS_WAIT(); asm volatile("" ::: "memory");
    const int c = lane & 7;
#pragma unroll
    for (int j = 0; j < 4; ++j) { const int n = (lane >> 3) + 8 * j; const LAS float* s = scr + (8 * c) * 33 + n;
        v4u o; o.x = pk2(s[0 * 33], s[1 * 33]); o.y = pk2(s[2 * 33], s[3 * 33]); o.z = pk2(s[4 * 33], s[5 * 33]); o.w = pk2(s[6 * 33], s[7 * 33]);
        *(GAS v4u*)(WT + (size_t)(n0 + n) * K + k0 + 8 * c) = o; }
    LDS_WAIT(); asm volatile("" ::: "memory");
}
__device__ __forceinline__ int win_src(int n) {
    const int ct = n >> 8, r = n & 255;
    if (ct < 2) return 0 + (ct - 0) * 256 + r;
    if (ct < 4) return 512 + (ct - 2) * 256 + r;
    if (ct < 8) return 1024 + (ct - 4) * 256 + r;
    if (ct < 12) return 2048 + (ct - 8) * 256 + r;
    if (ct < 14) return 6160 + (ct - 12) * 256 + r;
    if (ct == 14) return r < 16 ? 3072 + r : (r < 80 ? 6672 + (r - 16) : (r < 88 ? 6736 + (r - 80) : -1));
    if (ct < 19) return 3088 + (ct - 15) * 256 + r;
    if (ct < 23) return 4112 + (ct - 19) * 256 + r;
    if (ct < 27) return 5136 + (ct - 23) * 256 + r;
    if (ct < 31) return 6744 + (ct - 27) * 256 + r;
    return 7768 + (ct - 31) * 256 + r;
}
__device__ __forceinline__ void rms_row_to_bf16(const float* xrow, const float* gain, bf16* orow, int lane) {
    const GAS f32x4* xr = (const GAS f32x4*)xrow + lane; const GAS f32x4* gr = (const GAS f32x4*)gain + lane;
    f32x4 v[4]; float s = 0.f;
#pragma unroll
    for (int j = 0; j < 4; ++j) { v[j] = xr[64 * j]; s += (v[j].x * v[j].x + v[j].y * v[j].y) + (v[j].z * v[j].z + v[j].w * v[j].w); }
    const float rstd = 1.f / sqrtf(wave_sum(s) * (1.f / 1024.f) + 1e-6f);
    GAS unsigned long long* o8 = (GAS unsigned long long*)orow + lane;
#pragma unroll
    for (int j = 0; j < 4; ++j) { const f32x4 g = gr[64 * j];
        o8[64 * j] = (unsigned long long)pk2(v[j].x * rstd * g.x, v[j].y * rstd * g.y) | ((unsigned long long)pk2(v[j].z * rstd * g.z, v[j].w * rstd * g.w) << 32); }
}
__device__ __forceinline__ int rel_bucket_dev(int n) {
    if (n < 16) return n;
    const float nf = (float)n;
    int large = 16 + (int)(logf(nf / 16.0f) / 2.0794415416798357f * 16.0f);
    return large < 31 ? large : 31;
}
__device__ __forceinline__ void p0_prologue(Frame& F) {
    LAS float* scr = (LAS float*)(F.lds + RING_OFF + F.wave * 16384);
    const int gw = F.vcu * NWAVES + F.wave, NGW = F.G * NWAVES;
    unsigned char* ws = F.ws;
    constexpr int I_GU = (1024 / 64) * (5632 / 32), I_D = (2816 / 64) * (1024 / 32), I_WIN = (1024 / 64) * (NCT_WIN * 256 / 32), I_SQ = (1024 / 64) * (1024 / 32);
    constexpr int NITEMS = 2 * I_GU + 2 * I_D + I_WIN + 3 * I_SQ;
    for (int it = gw; it < NITEMS; it += NGW) {
        int r = it;
        if (r < I_GU) { const float* g = F.w1g; const float* u = F.w1u; const int nb = r % (5632 / 32); const bool up = ((nb * 32) & 128) != 0;
            p0_transpose_item(up ? u : g, DFF, 1024, (bf16*)(ws + WS_W1GU), 5632 / 32, scr, r, F.lane, [](int n) { return (n >> 8) * 128 + (n & 127); }); continue; } r -= I_GU;
        if (r < I_GU) { const float* g = F.w2g; const float* u = F.w2u; const int nb = r % (5632 / 32); const bool up = ((nb * 32) & 128) != 0;
            p0_transpose_item(up ? u : g, DFF, 1024, (bf16*)(ws + WS_W2GU), 5632 / 32, scr, r, F.lane, [](int n) { return (n >> 8) * 128 + (n & 127); }); continue; } r -= I_GU;
        if (r < I_D) { p0_transpose_item(F.w1d, 1024, DFF, (bf16*)(ws + WS_W1D), 1024 / 32, scr, r, F.lane, [](int n) { return n; }); continue; } r -= I_D;
        if (r < I_D) { p0_transpose_item(F.w2d, 1024, DFF, (bf16*)(ws + WS_W2D), 1024 / 32, scr, r, F.lane, [](int n) { return n; }); continue; } r -= I_D;
        if (r < I_WIN) { p0_transpose_item(F.win, 8792, 1024, (bf16*)(ws + WS_WIN), NCT_WIN * 256 / 32, scr, r, F.lane, [](int n) { return win_src(n); }); continue; } r -= I_WIN;
        if (r < I_SQ) { p0_transpose_item(F.wa, 1024, 1024, (bf16*)(ws + WS_WA), 32, scr, r, F.lane, [](int n) { return n; }); continue; } r -= I_SQ;
        if (r < I_SQ) { p0_transpose_item(F.wb, 1024, 1024, (bf16*)(ws + WS_WB), 32, scr, r, F.lane, [](int n) { return n; }); continue; } r -= I_SQ;
        p0_transpose_item(F.wo, 1024, 1024, (bf16*)(ws + WS_WO), 32, scr, r, F.lane, [](int n) { return n; });
    }
    bf16* XN = (bf16*)(ws + WS_XN);
    for (int m = gw; m < NREAL + NMETA; m += NGW)
        rms_row_to_bf16(m < NREAL ? F.x + (size_t)m * DM : F.meta + (size_t)(m - NREAL) * DM, F.n1, XN + (size_t)m * DM, F.lane);
    if (blockIdx.x == 0) {
        float* bt = (float*)(ws + WS_BIAST);
        for (int i = F.tid; i < 8 * 128; i += NWAVES * 64) { const int h = i >> 7, d = i & 127; bt[i] = (F.rb[rel_bucket_dev(d) * 8 + h] - F.rb[31 * 8 + h]) * 1.4426950408889634f; }
    }
}
__device__ __forceinline__ void p_final(Frame& F, const float* ssq) {
    const int gw = F.vcu * NWAVES + F.wave, NGW = F.G * NWAVES;
    for (int m = gw; m < NREAL; m += NGW) {
        const float rs = pg8::rstd_row(ssq, m);
        GAS f32x4* xr = (GAS f32x4*)(F.out + (size_t)m * DM) + F.lane; const GAS f32x4* gr = (const GAS f32x4*)F.nf + F.lane;
#pragma unroll
        for (int j = 0; j < 4; ++j) { const f32x4 v = xr[64 * j], g = gr[64 * j]; xr[64 * j] = v * rs * g; }
    }
}


typedef short s16x8 __attribute__((ext_vector_type(8)));
typedef short s16x4v __attribute__((ext_vector_type(4)));
typedef float f32x16 __attribute__((ext_vector_type(16)));
typedef unsigned u32x2 __attribute__((ext_vector_type(2)));
__device__ __forceinline__ int crow16(int r, int hi) { return (r & 3) + 8 * (r >> 2) + 4 * hi; }
__device__ __forceinline__ s16x4v ldtr(const LAS unsigned char* p) { return __builtin_bit_cast(s16x4v, __builtin_amdgcn_ds_read_tr16_b64_v4i16((LAS s16x4v*)p)); }
__device__ __forceinline__ s16x8 cat8(s16x4v a, s16x4v b) { return (s16x8){a[0], a[1], a[2], a[3], b[0], b[1], b[2], b[3]}; }
__device__ __forceinline__ float logsigmoid_f(float x) { return fminf(x, 0.f) - __logf(1.f + __expf(-fabsf(x))); }

constexpr int GLA_QT = 0, GLA_KT = 17408, GLA_VS = 34816, GLA_AM = 68608, GLA_EBL = 77824, GLA_GLR = 78336, GLA_PART = 82432;
constexpr int PQ = 272, PV = 528, PA = 144;

__device__ __forceinline__ void gla_phase_a(Frame& F) {
    unsigned char* ws = F.ws;
    bf16* GQ = (bf16*)(ws + WS_GQ); bf16* GK = (bf16*)(ws + WS_GK); bf16* GV = (bf16*)(ws + WS_GV);
    const float* GLR = (const float*)(ws + WS_GLR); float* LBUF = (float*)(ws + WS_LBUF); float* DBUF = (float*)(ws + WS_DBUF);
    LAS unsigned char* L = F.lds + RING_OFF;
    const int tid = F.tid, lane = F.lane, w = F.wave, hi = lane >> 5, l31 = lane & 31;
    const int d = tid & 127, tg = tid >> 7;
    for (int u = F.vcu; u < 132; u += F.G) {
        const bool meta = u >= 128;
        const int b = meta ? 0 : (u >> 6), h = meta ? (u - 128) : ((u >> 4) & 3), j = meta ? 0 : (u & 15);
        const float bl = F.blr[128 * h + d];
        float Bsup = 0.f;
        f32x16 S[4];
#pragma unroll
        for (int dt = 0; dt < 4; ++dt) S[dt] = (f32x16){};
        const int nch = meta ? 1 : 8, ntok = meta ? 16 : 64;
        for (int c = 0; c < nch; ++c) {
            const int row0 = meta ? NREAL : (b * TSEQ + 512 * j + 64 * c);
            { LAS float* gs = (LAS float*)(L + GLA_GLR);
              for (int i = tid; i < 64 * 16; i += 512) { const int t = i >> 4; gs[i] = t < ntok ? GLR[(size_t)(row0 + t) * 16 + (i & 15)] : 0.f; }
              const int vr = tid >> 3, seg = tid & 7;
#pragma unroll
              for (int q4 = 0; q4 < 4; ++q4) { v4u x = (v4u){0u, 0u, 0u, 0u}; if (vr < ntok) x = *(const v4u*)(GV + (size_t)(row0 + vr) * 1024 + 256 * h + 32 * seg + 8 * q4);
                  *(LAS v4u*)(L + GLA_VS + vr * PV + (32 * seg + 8 * q4) * 2) = x; } }
            __syncthreads();
            float cs[16]; float run = 0.f;
            { float wl[16];
#pragma unroll
              for (int i = 0; i < 16; ++i) wl[i] = F.wlr[i * 512 + 128 * h + d];
              asm volatile("" ::: "memory");
              const LAS float* gs = (const LAS float*)(L + GLA_GLR);
#pragma unroll
              for (int tt = 0; tt < 16; ++tt) { const int t = 16 * tg + tt; float x = bl;
#pragma unroll
                  for (int i = 0; i < 16; ++i) x += gs[t * 16 + i] * wl[i];
                  const float g = (t < ntok) ? logsigmoid_f(x) * (1.0f / 16.0f) : 0.f; run += g; cs[tt] = run; } }
            ((LAS float*)(L + GLA_PART))[tg * 128 + d] = run;
            __syncthreads();
            float pre = 0.f, tot = 0.f;
#pragma unroll
            for (int g4 = 0; g4 < 4; ++g4) { const float pv = ((const LAS float*)(L + GLA_PART))[g4 * 128 + d]; tot += pv; if (g4 < tg) pre += pv; }
            const float esup = __expf(Bsup);
#pragma unroll
            for (int tt = 0; tt < 16; ++tt) { const int t = 16 * tg + tt; const float bb = pre + cs[tt];
                float qv = 0.f, kv = 0.f;
                if (t < ntok) { kv = bf2f(GK[(size_t)(row0 + t) * 512 + 128 * h + d]); if (!meta) qv = bf2f(GQ[(size_t)(row0 + t) * 512 + 128 * h + d]); }
                const float qt = qv * __expf(bb), kt = kv * __expf(-bb);
                *(LAS unsigned short*)(L + GLA_QT + t * PQ + d * 2) = (unsigned short)f2bf(qt);
                *(LAS unsigned short*)(L + GLA_KT + t * PQ + d * 2) = (unsigned short)f2bf(kt);
                if (!meta) GQ[(size_t)(row0 + t) * 512 + 128 * h + d] = (bf16)f2bf(qt * esup); }
            if (tg == 0) ((LAS float*)(L + GLA_EBL))[d] = __expf(tot);
            Bsup += tot;
            __syncthreads();
            if (w < 3) {
                const int ti = w ? 1 : 0, si = (w == 2) ? 1 : 0;
                f32x16 a = (f32x16){};
#pragma unroll
                for (int ks = 0; ks < 8; ++ks) {
                    const s16x8 ka = *(const LAS s16x8*)(L + GLA_KT + (32 * si + l31) * PQ + (16 * ks + 8 * hi) * 2);
                    const s16x8 qb = *(const LAS s16x8*)(L + GLA_QT + (32 * ti + l31) * PQ + (16 * ks + 8 * hi) * 2);
                    a = __builtin_amdgcn_mfma_f32_32x32x16_bf16(ka, qb, a, 0, 0, 0);
                }
                const int t = 32 * ti + l31;
#pragma unroll
                for (int g4 = 0; g4 < 4; ++g4) { const int s0 = 32 * si + 8 * g4 + 4 * hi;
                    float v0 = a[4 * g4 + 0], v1 = a[4 * g4 + 1], v2 = a[4 * g4 + 2], v3 = a[4 * g4 + 3];
                    if (s0 + 0 > t) v0 = 0.f; if (s0 + 1 > t) v1 = 0.f; if (s0 + 2 > t) v2 = 0.f; if (s0 + 3 > t) v3 = 0.f;
                    *(LAS u32x2*)(L + GLA_AM + t * PA + s0 * 2) = (u32x2){pk2(v0, v1), pk2(v2, v3)}; }
            } else if (w == 3) {
                const int t = l31;
#pragma unroll
                for (int g4 = 0; g4 < 4; ++g4) *(LAS u32x2*)(L + GLA_AM + t * PA + (32 + 8 * g4 + 4 * hi) * 2) = (u32x2){0u, 0u};
            }
            __syncthreads();
            const int g1 = (lane >> 4) & 1, q = (lane & 15) >> 2, p = lane & 3;
            s16x8 vf[4];
#pragma unroll
            for (int ks = 0; ks < 4; ++ks) { const LAS unsigned char* vp = L + GLA_VS + (16 * ks + 8 * hi + q) * PV + (32 * w + 16 * g1 + 4 * p) * 2;
                vf[ks] = cat8(ldtr(vp), ldtr(vp + 4 * PV)); }
            if (!meta) {
#pragma unroll 1
                for (int ti = 0; ti < 2; ++ti) {
                    f32x16 o = (f32x16){};
                    const int t = 32 * ti + l31;
#pragma unroll
                    for (int ks = 0; ks < 4; ++ks) { const s16x8 af = *(const LAS s16x8*)(L + GLA_AM + t * PA + (16 * ks + 8 * hi) * 2);
                        o = __builtin_amdgcn_mfma_f32_32x32x16_bf16(af, vf[ks], o, 0, 0, 0); }
#pragma unroll
                    for (int dt = 0; dt < 4; ++dt) {
#pragma unroll
                        for (int s2 = 0; s2 < 2; ++s2) { const LAS unsigned char* qp = L + GLA_QT + t * PQ + (32 * dt + 16 * s2 + 4 * hi) * 2;
                            const s16x4v q0 = *(const LAS s16x4v*)qp, q1 = *(const LAS s16x4v*)(qp + 16);
                            v4u x; x.x = pk2(S[dt][8 * s2 + 0], S[dt][8 * s2 + 1]); x.y = pk2(S[dt][8 * s2 + 2], S[dt][8 * s2 + 3]); x.z = pk2(S[dt][8 * s2 + 4], S[dt][8 * s2 + 5]); x.w = pk2(S[dt][8 * s2 + 6], S[dt][8 * s2 + 7]);
                            o = __builtin_amdgcn_mfma_f32_32x32x16_bf16(cat8(q0, q1), __builtin_bit_cast(s16x8, x), o, 0, 0, 0); }
                        __builtin_amdgcn_sched_barrier(0);
                    }
                    { bf16* op = GV + (size_t)(row0 + 32 * ti + 4 * hi) * 1024 + 256 * h + 32 * w + l31; asm volatile("" : "+v"(op));
#pragma unroll
                      for (int r = 0; r < 16; ++r) op[((r & 3) + 8 * (r >> 2)) * 1024] = (bf16)f2bf(o[r]); }
                }
            }
            __builtin_amdgcn_sched_barrier(0);
#pragma unroll
            for (int dt = 0; dt < 4; ++dt) {
#pragma unroll
                for (int ks = 0; ks < 4; ++ks) { const LAS unsigned char* kp = L + GLA_KT + (16 * ks + 8 * hi + q) * PQ + (32 * dt + 16 * g1 + 4 * p) * 2;
                    const s16x8 kf = cat8(ldtr(kp), ldtr(kp + 4 * PQ));
                    S[dt] = __builtin_amdgcn_mfma_f32_32x32x16_bf16(kf, vf[ks], S[dt], 0, 0, 0); }
#pragma unroll
                for (int r = 0; r < 16; ++r) S[dt][r] *= ((const LAS float*)(L + GLA_EBL))[32 * dt + crow16(r, hi)];
                __builtin_amdgcn_sched_barrier(0);
            }
            __syncthreads();
        }
        float* Lu = LBUF + (size_t)u * 32768 + (4 * hi) * 256 + 32 * w + l31;
#pragma unroll
        for (int dt = 0; dt < 4; ++dt) { asm volatile("" : "+v"(Lu));
#pragma unroll
            for (int r = 0; r < 16; ++r) Lu[((r & 3) + 8 * (r >> 2)) * 256] = S[dt][r];
            Lu += 32 * 256; }
        if (tg == 0) DBUF[u * 128 + d] = __expf(Bsup);
    }
}

__device__ __forceinline__ void gla_phase_b(Frame& F) {
    unsigned char* ws = F.ws;
    const float* LBUF = (const float*)(ws + WS_LBUF); const float* DBUF = (const float*)(ws + WS_DBUF); bf16* TT = (bf16*)(ws + WS_TT);
    const int gt = F.vcu * (NWAVES * 64) + F.tid, NT = F.G * NWAVES * 64;
    for (int e = gt; e < 8 * 32768; e += NT) {
        const int bh = e >> 15, idx = e & 32767, dd = idx >> 8, h = bh & 3;
        float T = LBUF[(size_t)(128 + h) * 32768 + idx];
        for (int j = 0; j < 16; ++j) { const int u = bh * 16 + j;
            TT[(size_t)u * 32768 + idx] = (bf16)f2bf(T);
            T = DBUF[u * 128 + dd] * T + LBUF[(size_t)u * 32768 + idx]; }
    }
}

constexpr int GLC_TS = 0, GLC_OS = 67584, PO = 1056;
__device__ __forceinline__ void gla_phase_c(Frame& F) {
    unsigned char* ws = F.ws;
    const bf16* GQ = (const bf16*)(ws + WS_GQ); const bf16* GV = (const bf16*)(ws + WS_GV); bf16* GR = (bf16*)(ws + WS_GR); const bf16* TT = (const bf16*)(ws + WS_TT);
    LAS unsigned char* L = F.lds + RING_OFF;
    const int tid = F.tid, lane = F.lane, w = F.wave, hi = lane >> 5, l31 = lane & 31;
    const int g1 = (lane >> 4) & 1, q = (lane & 15) >> 2, p = lane & 3;
    for (int u2 = F.vcu; u2 < 256; u2 += F.G) {
        const int u = u2 >> 1, half = u2 & 1, b = u >> 6, h = (u >> 4) & 3, j = u & 15;
        __syncthreads();
        { const int tr = tid >> 2, seg = tid & 3;
#pragma unroll
          for (int q8 = 0; q8 < 8; ++q8) *(LAS v4u*)(L + GLC_TS + tr * PV + (64 * seg + 8 * q8) * 2) = *(const v4u*)(TT + (size_t)u * 32768 + tr * 256 + 64 * seg + 8 * q8); }
        __syncthreads();
        s16x8 tf[8];
#pragma unroll
        for (int ks = 0; ks < 8; ++ks) { const LAS unsigned char* tp = L + GLC_TS + (16 * ks + 8 * hi + q) * PV + (32 * w + 16 * g1 + 4 * p) * 2; tf[ks] = cat8(ldtr(tp), ldtr(tp + 4 * PV)); }
        for (int c = 0; c < 4; ++c) {
            const int row0 = b * TSEQ + 512 * j + 256 * half + 64 * c;
#pragma unroll 1
            for (int ti = 0; ti < 2; ++ti) {
                f32x16 o = (f32x16){};
                const bf16* qrow = GQ + (size_t)(row0 + 32 * ti + l31) * 512 + 128 * h + 8 * hi;
#pragma unroll
                for (int ks = 0; ks < 8; ++ks) { const s16x8 af = *(const s16x8*)(qrow + 16 * ks); o = __builtin_amdgcn_mfma_f32_32x32x16_bf16(af, tf[ks], o, 0, 0, 0); }
#pragma unroll
                for (int r = 0; r < 16; ++r) *(LAS float*)(L + GLC_OS + crow16(r, hi) * PO + (32 * w + l31) * 4) = o[r];
                __syncthreads();
#pragma unroll
                for (int rr = 0; rr < 4; ++rr) { const int lr = 4 * w + rr, row = row0 + 32 * ti + lr;
                    const f32x4 ov = *(const LAS f32x4*)(L + GLC_OS + lr * PO + lane * 16);
                    const u32x2 ol = *(const u32x2*)(GV + (size_t)row * 1024 + 256 * h + 4 * lane);
                    const u32x2 rv = *(const u32x2*)(GR + (size_t)row * 1024 + 256 * h + 4 * lane);
                    const f32x4 gn4 = *(const f32x4*)(F.gn + 4 * lane);
                    f32x4 t4; t4[0] = ov[0] + bf2f((unsigned short)(ol.x & 0xffff)); t4[1] = ov[1] + bf2f((unsigned short)(ol.x >> 16)); t4[2] = ov[2] + bf2f((unsigned short)(ol.y & 0xffff)); t4[3] = ov[3] + bf2f((unsigned short)(ol.y >> 16));
                    const float ss = wave_sum((t4[0] * t4[0] + t4[1] * t4[1]) + (t4[2] * t4[2] + t4[3] * t4[3]));
                    const float rs = 1.f / sqrtf(ss * (1.f / 256.f) + 1e-6f);
                    f32x4 y; y[0] = t4[0] * rs * gn4[0] * bf2f((unsigned short)(rv.x & 0xffff)); y[1] = t4[1] * rs * gn4[1] * bf2f((unsigned short)(rv.x >> 16));
                    y[2] = t4[2] * rs * gn4[2] * bf2f((unsigned short)(rv.y & 0xffff)); y[3] = t4[3] * rs * gn4[3] * bf2f((unsigned short)(rv.y >> 16));
                    *(u32x2*)(GR + (size_t)row * 1024 + 256 * h + 4 * lane) = (u32x2){pk2(y[0], y[1]), pk2(y[2], y[3])}; }
                __syncthreads();
            }
        }
    }
}


namespace ix {
constexpr int IQP = 1040;
constexpr int OFF_IQ = 0, OFF_H = 33280, HPW = 356  , OFF_M = OFF_H + 32 * HPW * 4, OFF_RI = OFF_M + 32 * MASKW * 4, OFF_CC = OFF_RI + 384;
constexpr int NB = 708, CAP = 128;
static_assert(32 * CAP * 8 <= 32 * HPW * 4 && OFF_CC + 128 <= RING_BYTES, "indexer LDS map");
__device__ __forceinline__ int score_bin(float s) {
    const unsigned b = __float_as_uint(s);
    int mag = (int)((b & 0x7fffffffu) >> 18) - (120 * 32 - 1);
    mag = mag < 0 ? 0 : (mag > 353 ? 353 : mag);
    return 354 + (mag ^ ((int)b >> 31));
}
__device__ __forceinline__ void tile_scores(f32x16& sc, const bf16* IKb, int kt, LAS unsigned char* L, int r32, int hi, const float (&iw)[8]) {
    s16x8 kf[4];
    const bf16* kp = IKb + (size_t)(32 * kt + r32) * 64 + 8 * hi;
#pragma unroll
    for (int d0 = 0; d0 < 4; ++d0) kf[d0] = *(const s16x8*)(kp + 16 * d0);
    sc = (f32x16){};
#pragma unroll
    for (int h = 0; h < 8; ++h) {
        f32x16 a = (f32x16){};
#pragma unroll
        for (int d0 = 0; d0 < 4; ++d0) { const s16x8 qf = *(const LAS s16x8*)(L + OFF_IQ + r32 * IQP + (h * 64 + 16 * d0 + 8 * hi) * 2);
            a = __builtin_amdgcn_mfma_f32_32x32x16_bf16(kf[d0], qf, a, 0, 0, 0); }
#pragma unroll
        for (int r = 0; r < 16; ++r) sc[r] += iw[h] * fmaxf(a[r], 0.f);
    }
#pragma unroll
    for (int r = 0; r < 16; ++r) sc[r] += 0.0f;
}
}

__device__ __forceinline__ void idx_phase(Frame& F) {
    using namespace ix;
    unsigned char* ws = F.ws;
    const bf16* IQ = (const bf16*)(ws + WS_IQ); const bf16* IKB = (const bf16*)(ws + WS_IKB); const float* IW = (const float*)(ws + WS_IW); unsigned* MASK = (unsigned*)(ws + WS_MASK);
    LAS unsigned char* L = F.lds + RING_OFF;
    const int tid = F.tid, lane = F.lane, w = F.wave, hi = lane >> 5, r32 = lane & 31;
    for (int v = F.vcu; v < 256; v += F.G) {
        const int b = v >> 7, m = v & 127;
#pragma unroll 1
        for (int ui = 0; ui < 2; ++ui) {
            const int qb = ui ? 255 - m : m;
            const int row0 = b * TSEQ + 32 * qb;
            const int qpos = NMETA + 32 * qb + r32;
            const int nkt = qb + 2;
            const bf16* IKb = IKB + (size_t)b * KVR * 64;
            __syncthreads();
            { const int rr = tid >> 4, seg = tid & 15;
#pragma unroll
              for (int q4 = 0; q4 < 4; ++q4) *(LAS v4u*)(L + OFF_IQ + rr * IQP + (32 * seg + 8 * q4) * 2) = *(const v4u*)(IQ + (size_t)(row0 + rr) * 512 + 32 * seg + 8 * q4); }
            for (int i = tid; i < 32 * HPW + 32 * MASKW + 128; i += 512) ((LAS unsigned*)(L + OFF_H))[i] = 0u;
            float iw[8];
            { const f32x4 a = *(const f32x4*)(IW + (size_t)(row0 + r32) * 8), c = *(const f32x4*)(IW + (size_t)(row0 + r32) * 8 + 4);
              iw[0] = a[0]; iw[1] = a[1]; iw[2] = a[2]; iw[3] = a[3]; iw[4] = c[0]; iw[5] = c[1]; iw[6] = c[2]; iw[7] = c[3]; }
            __syncthreads();
            for (int kt = w; kt < nkt; kt += 8) {
                f32x16 sc; tile_scores(sc, IKb, kt, L, r32, hi, iw);
                const bool edge = kt >= qb;
#pragma unroll
                for (int r = 0; r < 16; ++r) { const int key = 32 * kt + crow16(r, hi);
                    if (!edge || key <= qpos) { const int bin = score_bin(sc[r]);
                        __hip_atomic_fetch_add((LAS unsigned*)(L + OFF_H) + r32 * HPW + (bin >> 1), 1u << (16 * (bin & 1)), __ATOMIC_RELAXED, __HIP_MEMORY_SCOPE_WORKGROUP); } }
            }
            __syncthreads();
#pragma unroll 1
            for (int rr = 0; rr < 4; ++rr) {
                const int row = 4 * w + rr, n = NMETA + 32 * qb + row + 1;
                LAS int* ri = (LAS int*)(L + OFF_RI) + row * 3;
                if (n <= 256) { if (lane == 0) { ri[0] = -1; ri[1] = 0; ri[2] = 0; } continue; }
                const LAS unsigned short* hs = (const LAS unsigned short*)(L + OFF_H + row * HPW * 4);
                const int hib = NB - 1 - 12 * lane;
                int s = 0;
#pragma unroll
                for (int k = 0; k < 12; ++k) { const int bin = hib - k; if (bin >= 0) s += hs[bin]; }
                int P = s;
#pragma unroll
                for (int o = 1; o < 64; o <<= 1) { const int t = __shfl_up(P, o); if (lane >= o) P += t; }
                const unsigned long long bal = __ballot(P >= 256);
                const int first = bal ? __builtin_ctzll(bal) : 63;
                if (lane == first) { int chi = P - s; int bs = -1, need = 0, cb = 0;
                    for (int k = 0; k < 12; ++k) { const int bin = hib - k; if (bin < 0) break; const int c = hs[bin];
                        if (chi + c >= 256) { bs = bin; need = 256 - chi; cb = c; break; } chi += c; }
                    ri[0] = bs; ri[1] = need; ri[2] = cb; }
            }
            __syncthreads();
            const int bstar = ((const LAS int*)(L + OFF_RI))[r32 * 3];
            for (int kt = w; kt < nkt; kt += 8) {
                f32x16 sc; tile_scores(sc, IKb, kt, L, r32, hi, iw);
                const bool edge = kt >= qb; unsigned bits = 0u;
#pragma unroll
                for (int r = 0; r < 16; ++r) { const int key = 32 * kt + crow16(r, hi);
                    if (!edge || key <= qpos) { const int bin = score_bin(sc[r]);
                        if (bin > bstar) bits |= 1u << crow16(r, hi);
                        else if (bin == bstar) { const unsigned slot = __hip_atomic_fetch_add((LAS unsigned*)(L + OFF_CC) + r32, 1u, __ATOMIC_RELAXED, __HIP_MEMORY_SCOPE_WORKGROUP);
                            if (slot < (unsigned)CAP) { LAS unsigned* cd = (LAS unsigned*)(L + OFF_H) + (r32 * CAP + slot) * 2; cd[0] = __float_as_uint(sc[r]); cd[1] = (unsigned)key; } } } }
                if (bits) __hip_atomic_fetch_or((LAS unsigned*)(L + OFF_M) + r32 * MASKW + kt, bits, __ATOMIC_RELAXED, __HIP_MEMORY_SCOPE_WORKGROUP);
            }
            __syncthreads();
#pragma unroll 1
            for (int rr = 0; rr < 4; ++rr) {
                const int row = 4 * w + rr;
                const int need = ((const LAS int*)(L + OFF_RI))[row * 3 + 1];
                int cnt = (int)((const LAS unsigned*)(L + OFF_CC))[row]; cnt = cnt > CAP ? CAP : cnt;
                const LAS unsigned* cd = (const LAS unsigned*)(L + OFF_H) + row * CAP * 2;
                for (int c = lane; c < cnt; c += 64) {
                    const float sc_ = __uint_as_float(cd[2 * c]); const unsigned ic = cd[2 * c + 1];
                    int rank = 0;
                    for (int c2 = 0; c2 < cnt; ++c2) { const float s2 = __uint_as_float(cd[2 * c2]); const unsigned i2 = cd[2 * c2 + 1]; rank += (s2 > sc_ || (s2 == sc_ && i2 < ic)) ? 1 : 0; }
                    if (rank < need) __hip_atomic_fetch_or((LAS unsigned*)(L + OFF_M) + row * MASKW + (ic >> 5), 1u << (ic & 31), __ATOMIC_RELAXED, __HIP_MEMORY_SCOPE_WORKGROUP);
                }
            }
            __syncthreads();
            const int nw = 2 * (4 * (qb >> 3) + 6);
            for (int i = tid; i < 32 * MASKW; i += 512) { const int row = i / MASKW, wd = i - row * MASKW;
                if (wd < nw) MASK[(size_t)(row0 + row) * MASKW + wd] = ((const LAS unsigned*)(L + OFF_M))[i]; }
        }
    }
}


namespace at {
constexpr int D = 128, NW = 8, QBLK = 32, KVBLK = 64, LDX = 1024;
constexpr float THR = 8.f;
constexpr size_t SHM_V = KVBLK * D * 2, SHM_K = KVBLK * D * 2;
constexpr int OFF_WS = 2 * SHM_V + 2 * SHM_K, OFF_BT = OFF_WS + NW * 64 * 4;
#define KSWZ(row, colB) ((row) * 256 + ((colB) ^ (((row) & 7) << 4)))
#define SBAR() __builtin_amdgcn_sched_barrier(0)
__device__ __forceinline__ unsigned cvtpk(float lo, float hi) { unsigned r; asm volatile("v_cvt_pk_bf16_f32 %0, %1, %2" : "=v"(r) : "v"(lo), "v"(hi)); return r; }
__device__ __forceinline__ void partialSM(f32x16& p0, f32x16& p1, float& m_reg, float& mn, float& alpha) {
  float pmax = p0[0];
#pragma unroll
  for (int r = 1; r < 16; ++r) pmax = fmaxf(pmax, p0[r]);
#pragma unroll
  for (int r = 0; r < 16; ++r) pmax = fmaxf(pmax, p1[r]);
  { auto rr = __builtin_amdgcn_permlane32_swap(__float_as_uint(pmax), __float_as_uint(pmax), false, false);
    pmax = fmaxf(__uint_as_float(rr[0]), __uint_as_float(rr[1])); }
  if (__builtin_expect(__all(pmax - m_reg <= THR), 1)) { mn = m_reg; alpha = 1.f; }
  else { mn = fmaxf(m_reg, pmax); alpha = __builtin_amdgcn_exp2f(m_reg - mn); m_reg = mn; }
#pragma unroll
  for (int r = 0; r < 16; ++r) p0[r] = p0[r] - mn;
#pragma unroll
  for (int r = 0; r < 16; ++r) p1[r] = p1[r] - mn;
#pragma unroll
  for (int r = 0; r < 16; ++r) p0[r] = __builtin_amdgcn_exp2f(p0[r]);
}
__device__ __forceinline__ void finishSM(f32x16& p0, f32x16& p1, float alpha, float& l_reg, s16x8& pa0, s16x8& pa1, s16x8& pa2, s16x8& pa3) {
#pragma unroll
  for (int r = 0; r < 16; ++r) p1[r] = __builtin_amdgcn_exp2f(p1[r]);
  float ps = 0;
#pragma unroll
  for (int r = 0; r < 16; ++r) ps += p0[r];
#pragma unroll
  for (int r = 0; r < 16; ++r) ps += p1[r];
  { auto rr = __builtin_amdgcn_permlane32_swap(__float_as_uint(ps), __float_as_uint(ps), false, false);
    ps = __uint_as_float(rr[0]) + __uint_as_float(rr[1]); }
  l_reg = l_reg * alpha + ps;
#define PK4(P, BASE, OUT) do { unsigned a0 = cvtpk(P[BASE + 0], P[BASE + 1]), a1 = cvtpk(P[BASE + 2], P[BASE + 3]);   \
    unsigned b0 = cvtpk(P[BASE + 4], P[BASE + 5]), b1 = cvtpk(P[BASE + 6], P[BASE + 7]);                              \
    auto r0 = __builtin_amdgcn_permlane32_swap(a0, b0, false, false); auto r1 = __builtin_amdgcn_permlane32_swap(a1, b1, false, false); \
    v4u w_ = {r0[0], r1[0], r0[1], r1[1]}; OUT = __builtin_bit_cast(s16x8, w_); } while (0)
  PK4(p0, 0, pa0); PK4(p0, 8, pa1); PK4(p1, 0, pa2); PK4(p1, 8, pa3);
#undef PK4
}
__device__ __forceinline__ void qkt(f32x16& p0, f32x16& p1, const unsigned char* Ks, const s16x8* qr, int r32, int hi) {
#pragma unroll
  for (int d0 = 0; d0 < 8; ++d0) { const int cb = (d0 * 16 + hi * 8) * 2;
    const s16x8 b0 = *reinterpret_cast<const s16x8*>(Ks + KSWZ(r32, cb));
    const s16x8 b1 = *reinterpret_cast<const s16x8*>(Ks + KSWZ(32 + r32, cb));
    p0 = __builtin_amdgcn_mfma_f32_32x32x16_bf16(b0, qr[d0], p0, 0, 0, 0);
    p1 = __builtin_amdgcn_mfma_f32_32x32x16_bf16(b1, qr[d0], p1, 0, 0, 0); }
}
__device__ __forceinline__ int v_st(int k, int c) { const int kk = (k & ~0xC) | ((k & 4) << 1) | ((k & 8) >> 1); return ((kk >> 3) * 4 + (c >> 5)) * 512 + ((kk & 7) * 32 + (c & 31)) * 2; }
__device__ __forceinline__ int v_rd_base(int lane) { return ((lane & 3) << 3) | (((lane >> 2) & 3) << 6) | (((lane >> 4) & 1) << 5) | (((lane >> 5) & 1) << 8); }
constexpr int v_rd_off(int d0, int ks, int half) { return d0 * 512 + ks * 4096 + half * 2048; }
template <int OFF> __device__ __forceinline__ s16x4v tr_read(int vb) {
  s16x4v r; asm volatile("ds_read_b64_tr_b16 %0, %1 offset:%2" : "=&v"(r) : "v"(vb), "i"(OFF) : "memory"); return r;
}
template <int D0> __device__ __forceinline__ void pv_one(f32x16& od, int vb, s16x8 pa0, s16x8 pa1, s16x8 pa2, s16x8 pa3) {
  const s16x4v l0 = tr_read<v_rd_off(D0, 0, 0)>(vb), h0 = tr_read<v_rd_off(D0, 0, 1)>(vb), l1 = tr_read<v_rd_off(D0, 1, 0)>(vb), h1 = tr_read<v_rd_off(D0, 1, 1)>(vb);
  const s16x4v l2 = tr_read<v_rd_off(D0, 2, 0)>(vb), h2 = tr_read<v_rd_off(D0, 2, 1)>(vb), l3 = tr_read<v_rd_off(D0, 3, 0)>(vb), h3 = tr_read<v_rd_off(D0, 3, 1)>(vb);
  asm volatile("s_waitcnt lgkmcnt(0)" ::: "memory"); SBAR();
#define PK(L, H) (s16x8){L[0], L[1], L[2], L[3], H[0], H[1], H[2], H[3]}
  od = __builtin_amdgcn_mfma_f32_32x32x16_bf16(pa0, PK(l0, h0), od, 0, 0, 0);
  od = __builtin_amdgcn_mfma_f32_32x32x16_bf16(pa1, PK(l1, h1), od, 0, 0, 0);
  od = __builtin_amdgcn_mfma_f32_32x32x16_bf16(pa2, PK(l2, h2), od, 0, 0, 0);
  od = __builtin_amdgcn_mfma_f32_32x32x16_bf16(pa3, PK(l3, h3), od, 0, 0, 0);
#undef PK
}
__device__ __forceinline__ void pv_d0(f32x16* o, int vb, s16x8 pa0, s16x8 pa1, s16x8 pa2, s16x8 pa3) {
  pv_one<0>(o[0], vb, pa0, pa1, pa2, pa3); pv_one<1>(o[1], vb, pa0, pa1, pa2, pa3); pv_one<2>(o[2], vb, pa0, pa1, pa2, pa3); pv_one<3>(o[3], vb, pa0, pa1, pa2, pa3);
}
__device__ __forceinline__ void mk_init(f32x16& p0, f32x16& p1, u32x2 mw, int t, int qpos, int hi, bool near, const float* bt) {
  const unsigned w0 = mw.x >> (4 * hi), w1 = mw.y >> (4 * hi);
  const float NEG = -INFINITY;
  if (near) {
    const int db = qpos - (64 * t + 4 * hi);
#pragma unroll
    for (int r = 0; r < 16; ++r) { const int c = (r & 3) + 8 * (r >> 2);
      int d0 = db - c, d1 = db - 32 - c; d0 = d0 < 0 ? 0 : (d0 > 127 ? 127 : d0); d1 = d1 < 0 ? 0 : (d1 > 127 ? 127 : d1);
      p0[r] = ((w0 >> c) & 1u) ? bt[d0] : NEG; p1[r] = ((w1 >> c) & 1u) ? bt[d1] : NEG; }
  } else {
#pragma unroll
    for (int r = 0; r < 16; ++r) { const int c = (r & 3) + 8 * (r >> 2);
      p0[r] = ((w0 >> c) & 1u) ? 0.f : NEG; p1[r] = ((w1 >> c) & 1u) ? 0.f : NEG; }
  }
}

__device__ __forceinline__ void attn_unit(const bf16* __restrict__ Qb, const bf16* __restrict__ Kh, const bf16* __restrict__ Vh, bf16* Ob, const unsigned* __restrict__ Mb, int qpos0, int NT, const float* btg, unsigned char* lds) {
  int tid_ = threadIdx.x; asm volatile("" : "+v"(tid_));
  const int tid = tid_, wid = __builtin_amdgcn_readfirstlane(tid >> 6), lane = tid & 63, r32 = lane & 31, hi = lane >> 5;
  unsigned char* V_lds = lds; unsigned char* K_lds = lds + 2 * SHM_V;
  float* ws = (float*)(lds + OFF_WS) + wid * 64; float* li_l = ws; float* al_l = ws + 32;
  float* bt = (float*)(lds + OFF_BT);
  if (tid < 128) bt[tid] = btg[tid];
  float m_reg = -1e30f, l_reg = 0; f32x16 o[4] = {}; s16x8 qr[8];
  const bf16* Qw = Qb + (long)(wid * QBLK + r32) * LDX + hi * 8;
#pragma unroll
  for (int d0 = 0; d0 < 8; ++d0) qr[d0] = *reinterpret_cast<const s16x8*>(Qw + d0 * 16);
  const int sr = tid >> 4, sc = (tid & 15) * 8, vst0 = v_st(sr, sc), kst0 = KSWZ(sr, sc * 2);
  const int vb0 = (int)(uintptr_t)V_lds + v_rd_base(lane);
  struct { s16x8 vs0, vs1, ks0, ks1; } sr_[1];
  const int qpos = qpos0 + wid * QBLK + r32, qmin = qpos0 + wid * QBLK;
  const unsigned moff = (unsigned)((wid * QBLK + r32) * MASKW * 4);
  const unsigned voff0 = (unsigned)((sr * LDX + sc) * 2);
#define SLOAD(i, k0) do { const char* vt_ = (const char*)Vh + (size_t)(k0) * (LDX * 2); const char* kt_ = (const char*)Kh + (size_t)(k0) * (LDX * 2); \
    sr_[i].vs0 = *(const s16x8*)(vt_ + voff0); sr_[i].vs1 = *(const s16x8*)((vt_ + 32 * LDX * 2) + voff0); \
    sr_[i].ks0 = *(const s16x8*)(kt_ + voff0); sr_[i].ks1 = *(const s16x8*)((kt_ + 32 * LDX * 2) + voff0); } while (0)
#define SWRITE(b, i) do { *(s16x8*)(V_lds + (b) * SHM_V + vst0) = sr_[i].vs0;          \
    *(s16x8*)(V_lds + (b) * SHM_V + 8192 + vst0) = sr_[i].vs1;               \
    *(s16x8*)(K_lds + (b) * SHM_K + kst0) = sr_[i].ks0;                       \
    *(s16x8*)(K_lds + (b) * SHM_K + 8192 + kst0) = sr_[i].ks1; } while (0)
#define SWAIT() asm volatile("s_waitcnt vmcnt(0)" ::: "memory")
#define RESC(a) do { if (__any((a) < 1.f)) { if (hi == 0) al_l[r32] = (a); asm volatile("s_waitcnt lgkmcnt(0)" ::: "memory"); \
    _Pragma("unroll") for (int d = 0; d < 4; ++d) _Pragma("unroll") for (int r = 0; r < 16; ++r) o[d][r] *= al_l[crow16(r, hi)]; } } while (0)
#define MLOAD(t) (*(const u32x2*)((const char*)Mb + (size_t)(8 * (t)) + moff))
#define NEAR(t) (64 * (t) + 63 + 113 > qmin)
  f32x16 pA0, pA1, pB0, pB1; float mnA, mnB, alA, alB; s16x8 pa0, pa1, pa2, pa3;
  constexpr int SE = 0, SO = 0;
  SLOAD(SE, 0); asm volatile("s_waitcnt vmcnt(0)" ::: "memory"); SWRITE(0, SE); __syncthreads();
  mk_init(pA0, pA1, MLOAD(0), 0, qpos, hi, NEAR(0), bt);
  qkt(pA0, pA1, K_lds, qr, r32, hi); partialSM(pA0, pA1, m_reg, mnA, alA);
  SLOAD(SO, KVBLK);
  SWAIT(); SWRITE(1, SO); __syncthreads();
  for (int j = 1; j + 1 < NT; j += 2) {
    mk_init(pB0, pB1, MLOAD(j), j, qpos, hi, NEAR(j), bt);
    SBAR(); qkt(pB0, pB1, K_lds + SHM_K, qr, r32, hi);
    finishSM(pA0, pA1, alA, l_reg, pa0, pa1, pa2, pa3); SBAR();
    SLOAD(SO, (j + 1) * KVBLK); SBAR();
    pv_d0(o, vb0, pa0, pa1, pa2, pa3); partialSM(pB0, pB1, m_reg, mnB, alB);
    __syncthreads(); SWAIT(); SWRITE(0, SE);
    RESC(alB); __syncthreads();
    mk_init(pA0, pA1, MLOAD(j + 1), j + 1, qpos, hi, NEAR(j + 1), bt);
    SBAR(); qkt(pA0, pA1, K_lds, qr, r32, hi);
    finishSM(pB0, pB1, alB, l_reg, pa0, pa1, pa2, pa3); SBAR();
    SLOAD(SE, (j + 2) * KVBLK); SBAR();
    pv_d0(o, vb0 + (int)SHM_V, pa0, pa1, pa2, pa3); partialSM(pA0, pA1, m_reg, mnA, alA);
    __syncthreads(); SWAIT(); SWRITE(1, SO);
    RESC(alA); __syncthreads();
  }
  mk_init(pB0, pB1, MLOAD(NT - 1), NT - 1, qpos, hi, NEAR(NT - 1), bt);
  SBAR(); qkt(pB0, pB1, K_lds + SHM_K, qr, r32, hi);
  finishSM(pA0, pA1, alA, l_reg, pa0, pa1, pa2, pa3); SBAR();
  pv_d0(o, vb0, pa0, pa1, pa2, pa3); partialSM(pB0, pB1, m_reg, mnB, alB);
  __syncthreads(); RESC(alB);
  finishSM(pB0, pB1, alB, l_reg, pa0, pa1, pa2, pa3); SBAR();
  pv_d0(o, vb0 + (int)SHM_V, pa0, pa1, pa2, pa3);
  if (hi == 0) li_l[r32] = l_reg; asm volatile("s_waitcnt lgkmcnt(0)" ::: "memory");
  float rli[16];
#pragma unroll
  for (int r = 0; r < 16; ++r) rli[r] = __builtin_amdgcn_rcpf(li_l[crow16(r, hi)]);
  bf16* Ow = Ob + (long)(wid * QBLK + 4 * hi) * LDX + r32; asm volatile("" : "+v"(Ow));
#pragma unroll
  for (int r = 0; r < 16; ++r) {
#pragma unroll
    for (int d0 = 0; d0 < 4; ++d0) Ow[(long)((r & 3) + 8 * (r >> 2)) * LDX + d0 * 32] = (bf16)f2bf(o[d0][r] * rli[r]); }
  __syncthreads();
#undef SLOAD
#undef SWRITE
#undef SWAIT
#undef RESC
#undef MLOAD
#undef NEAR
}
#undef KSWZ
#undef SBAR
}

__device__ __forceinline__ void attn_phase(Frame& F) {
    unsigned char* ws = F.ws;
    bf16* DQ = (bf16*)(ws + WS_DQ); const bf16* DK = (const bf16*)(ws + WS_DKB); const bf16* DV = (const bf16*)(ws + WS_DVB);
    const unsigned* MASK = (const unsigned*)(ws + WS_MASK); const float* BT = (const float*)(ws + WS_BIAST);
    { const int v = F.vcu & 255;
        const int bh = v >> 4, s = v & 15, b = bh >> 3, h = bh & 7;
#pragma unroll 1
        for (int i = 0; i < 2; ++i) {
            const int jq = i ? 31 - s : s;
            const size_t qrow = (size_t)b * TSEQ + 256 * jq;
            at::attn_unit(DQ + qrow * 1024 + 128 * h, DK + (size_t)b * KVR * 1024 + 128 * h, DV + (size_t)b * KVR * 1024 + 128 * h, DQ + qrow * 1024 + 128 * h,
                          MASK + qrow * MASKW, NMETA + 256 * jq, 4 * jq + 6, BT + 128 * h, (unsigned char*)(F.lds + RING_OFF));
        }
    }
}


#ifndef MK_N_LAUNCHES
#define MK_N_LAUNCHES 1
#endif
#ifndef DBG_STOP
#define DBG_STOP 99
#endif
constexpr int NPH = 16;
constexpr int N_LAUNCHES = MK_N_LAUNCHES;
static_assert(N_LAUNCHES == 1 || N_LAUNCHES == NPH, "MK_N_LAUNCHES is 1 or NPH");
struct Args { const float* in[20]; float* out; unsigned char* ws; int ph_lo, ph_hi; };
__global__ void __launch_bounds__(NWAVES * 64, 2) fwd_kernel(Args args) {
    extern __shared__ __attribute__((aligned(16))) unsigned char lds[];
    Frame F;
    F.lds = (LAS unsigned char*)lds;
    F.MISC = (volatile LAS unsigned*)(F.lds + MISC_OFF);
    F.tid = threadIdx.x; F.lane = F.tid & 63; F.wave = __builtin_amdgcn_readfirstlane(F.tid >> 6);
    F.G = gridDim.x; { const int bx = blockIdx.x; F.vcu = (F.G % 8 == 0) ? (bx % 8) * (F.G / 8) + bx / 8 : bx; }
    unsigned char* ws = args.ws; F.ws = ws;
    F.ctl = (gu32*)(ws + WS_CTL);
    F.x = args.in[0]; F.meta = args.in[1]; F.n1 = args.in[2]; F.w1g = args.in[3]; F.w1u = args.in[4]; F.w1d = args.in[5]; F.nm = args.in[6]; F.win = args.in[7];
    F.wlr = args.in[8]; F.blr = args.in[9]; F.gn = args.in[10]; F.wa = args.in[11]; F.wb = args.in[12]; F.wo = args.in[13]; F.rb = args.in[14]; F.n2 = args.in[15];
    F.w2g = args.in[16]; F.w2u = args.in[17]; F.w2d = args.in[18]; F.nf = args.in[19]; F.out = args.out;
    for (int u = F.tid; u < (LDS_BYTES - LDSCTL_OFF) / 4; u += NWAVES * 64) ((LAS unsigned*)(F.lds + LDSCTL_OFF))[u] = 0u;
    __syncthreads();
    XcdBarrier bar; bar.bar = (unsigned*)(F.ctl + CW_BAR); bar.x = 0; bar.st = nullptr;
    if (N_LAUNCHES == 1) bar = xcd_barrier_post((unsigned*)(F.ctl + CW_BAR), F.MISC + 8);
    const int lo = args.ph_lo, hi = args.ph_hi;
#define IN(k) (lo <= (k) && (k) < hi && (k) < DBG_STOP)
#define SEAM() do { if (N_LAUNCHES == 1) xcd_barrier(bar); } while (0)
    typedef pg8::bf16_t b16;
    b16* XN = (b16*)(ws + WS_XN);
    float* SSQA = (float*)(ws + WS_SSQA); float* SSQB = (float*)(ws + WS_SSQB); float* SSQC = (float*)(ws + WS_SSQC);

    if (IN(0)) { p0_prologue(F); SEAM(); }
    if (IN(1)) {
        pg8::Gemm g{XN, (const b16*)(ws + WS_W1GU), NROWS, 5632, 1024, nullptr, nullptr}; pg8::StaticOrder S; S.init(NROWS, 5632, F.G, (int)blockIdx.x);
        pg8::EpiSwiglu E{(b16*)(ws + WS_HB), DFF, nullptr};
        pg8::gemm_phase<pg8::EpiSwiglu, pg8::StaticOrder, true, true>(F.lds + RING_OFF, g, S, E);
        SEAM();
    }
    if (IN(2)) {
        pg8::Gemm g{(const b16*)(ws + WS_HB), (const b16*)(ws + WS_W1D), NROWS, 1024, DFF, nullptr, nullptr}; pg8::StaticOrder S; S.init(NROWS, 1024, F.G, (int)blockIdx.x);
        pg8::EpiResid E{F.x, F.out, F.meta, (float*)(ws + WS_METAH), 0.5f, XN, F.nm, SSQA, NREAL};
        pg8::gemm_phase<pg8::EpiResid, pg8::StaticOrder, true, true>(F.lds + RING_OFF, g, S, E);
        SEAM();
    }
    pg8::EpiWin EW{SSQA, 0, (b16*)(ws + WS_GQ), (b16*)(ws + WS_GK), (b16*)(ws + WS_GV), (b16*)(ws + WS_GR), (b16*)(ws + WS_IQ), (b16*)(ws + WS_DQ), (b16*)(ws + WS_DKB), (b16*)(ws + WS_DVB),
                   (b16*)(ws + WS_GA), (b16*)(ws + WS_GB), (b16*)(ws + WS_IKB), (float*)(ws + WS_GLR), (float*)(ws + WS_IW)};
    if (IN(3)) {
        pg8::Gemm g{XN, (const b16*)(ws + WS_WIN), NROWS, 15 * 256, 1024, nullptr, nullptr}; pg8::StaticOrder S; S.init(NROWS, 15 * 256, F.G, (int)blockIdx.x);
        EW.ct0 = 0;
        pg8::gemm_phase<pg8::EpiWin, pg8::StaticOrder, true, true>(F.lds + RING_OFF, g, S, EW);
        SEAM();
    }
    if (IN(4)) { gla_phase_a(F); SEAM(); }
    if (IN(5)) { gla_phase_b(F); SEAM(); }
    if (IN(6)) { gla_phase_c(F); SEAM(); }
    if (IN(7)) { idx_phase(F); SEAM(); }
    if (IN(8)) {
        pg8::Gemm g{XN, (const b16*)(ws + WS_WIN) + (size_t)15 * 256 * 1024, NROWS, 12 * 256, 1024, nullptr, nullptr}; pg8::StaticOrder S; S.init(NROWS, 12 * 256, F.G, (int)blockIdx.x);
        EW.ct0 = 15;
        pg8::gemm_phase<pg8::EpiWin, pg8::StaticOrder, true, true>(F.lds + RING_OFF, g, S, EW);
        SEAM();
    }
    if (IN(9)) { attn_phase(F); SEAM(); }
    if (IN(10)) {
        pg8::Gemm g{XN, (const b16*)(ws + WS_WIN) + (size_t)27 * 256 * 1024, NREAL, 8 * 256, 1024, nullptr, nullptr}; pg8::StaticOrder S; S.init(NREAL, 8 * 256, F.G, (int)blockIdx.x);
        EW.ct0 = 27;
        pg8::gemm_phase<pg8::EpiWin, pg8::StaticOrder, true, true>(F.lds + RING_OFF, g, S, EW);
        SEAM();
    }
    if (IN(11)) {
        pg8::Gemm g{(const b16*)(ws + WS_GR), (const b16*)(ws + WS_WA), NREAL, 1024, 1024, (const b16*)(ws + WS_DQ), (const b16*)(ws + WS_WB)}; pg8::PairOrder S; S.init(NREAL, 1024, F.G, (int)blockIdx.x);
        pg8::EpiMerge E{(const b16*)(ws + WS_GA), (const b16*)(ws + WS_GB), XN};
        pg8::gemm_phase<pg8::EpiMerge, pg8::PairOrder, false, true>(F.lds + RING_OFF, g, S, E);
        SEAM();
    }
    if (IN(12)) {
        pg8::Gemm g{XN, (const b16*)(ws + WS_WO), NREAL, 1024, 1024, nullptr, nullptr}; pg8::StaticOrder S; S.init(NREAL, 1024, F.G, (int)blockIdx.x);
        pg8::EpiResid E{F.out, F.out, nullptr, nullptr, 1.0f, (b16*)(ws + WS_A3), F.n2, SSQB, NREAL};
        pg8::gemm_phase<pg8::EpiResid, pg8::StaticOrder, true, true>(F.lds + RING_OFF, g, S, E);
        SEAM();
    }
    if (IN(13)) {
        pg8::Gemm g{(const b16*)(ws + WS_A3), (const b16*)(ws + WS_W2GU), NREAL, 5632, 1024, nullptr, nullptr}; pg8::StaticOrder S; S.init(NREAL, 5632, F.G, (int)blockIdx.x);
        pg8::EpiSwiglu E{(b16*)(ws + WS_HB2), DFF, SSQB};
        pg8::gemm_phase<pg8::EpiSwiglu, pg8::StaticOrder, true, true>(F.lds + RING_OFF, g, S, E);
        SEAM();
    }
    if (IN(14)) {
        pg8::Gemm g{(const b16*)(ws + WS_HB2), (const b16*)(ws + WS_W2D), NREAL, 1024, DFF, nullptr, nullptr}; pg8::StaticOrder S; S.init(NREAL, 1024, F.G, (int)blockIdx.x);
        pg8::EpiResid E{F.out, F.out, nullptr, nullptr, 0.5f, nullptr, nullptr, SSQC, NREAL};
        pg8::gemm_phase<pg8::EpiResid, pg8::StaticOrder, true, true>(F.lds + RING_OFF, g, S, E);
        SEAM();
    }

    if (lo <= 15 && 15 < hi) { p_final(F, DBG_STOP <= 12 ? SSQA : (DBG_STOP <= 14 ? SSQB : SSQC)); }
#undef IN
#undef SEAM
}

extern "C" void kernel_launch(void* const* d_in, const int* in_sizes, int n_in, void* d_out, int out_size, void* d_ws, size_t ws_size, hipStream_t stream) {
    static int grid = 0;
    if (grid == 0) {
        if (n_in != 20 || out_size != NREAL * DM || ws_size < WS_END) { fprintf(stderr, "kernel_launch: unexpected shapes: n_in %d out %d ws %zu\n", n_in, out_size, ws_size); grid = -1; return; }
        int dev = 0, cus = 0, per_cu = 0;
        if (hipGetDevice(&dev) != hipSuccess || hipDeviceGetAttribute(&cus, hipDeviceAttributeMultiprocessorCount, dev) != hipSuccess) { grid = -1; return; }
        if (hipFuncSetAttribute((const void*)fwd_kernel, hipFuncAttributeMaxDynamicSharedMemorySize, LDS_BYTES) != hipSuccess) { fprintf(stderr, "kernel_launch: hipFuncSetAttribute failed\n"); grid = -1; return; }
        if (hipOccupancyMaxActiveBlocksPerMultiprocessor(&per_cu, (const void*)fwd_kernel, NWAVES * 64, LDS_BYTES) != hipSuccess || per_cu < 1)
            fprintf(stderr, "kernel_launch: note: occupancy query reports %d workgroups per CU\n", per_cu);
        (void)hipGetLastError();
        grid = cus;
        if (grid > 256) grid = 256;
    }
    if (grid < 0) return;
    if (hipMemsetAsync((char*)d_ws + WS_CTL, 0, CTL_ZERO_BYTES, stream) != hipSuccess) { fprintf(stderr, "kernel_launch: memset failed\n"); return; }
    Args a{};
    for (int i = 0; i < 20; ++i) a.in[i] = (const float*)d_in[i];
    a.out = (float*)d_out; a.ws = (unsigned char*)d_ws;
    for (int li = 0; li < N_LAUNCHES; ++li) {
        a.ph_lo = (N_LAUNCHES == 1) ? 0 : li; a.ph_hi = (N_LAUNCHES == 1) ? NPH : li + 1;
        hipLaunchKernelGGL(fwd_kernel, dim3(grid), dim3(NWAVES * 64), LDS_BYTES, stream, a);
        const hipError_t le = hipPeekAtLastError();
        if (le != hipSuccess) { fprintf(stderr, "kernel_launch: launch %d failed: %s\n", li, hipGetErrorName(le)); break; }
    }
}
```

```cpp
#include <hip/hip_runtime.h>
#include <cstdio>
#include <cstdint>
#include <cmath>

namespace pg8 {
#define PG8_LAS __attribute__((address_space(3)))
typedef unsigned short bf16_t;
typedef short bf16x8 __attribute__((ext_vector_type(8)));
typedef float f32x4 __attribute__((ext_vector_type(4)));
typedef unsigned u32x4 __attribute__((ext_vector_type(4)));
constexpr int BM = 256, BK = 64, HALF = 128, HTB = HALF * BK * 2  , STAGE_BYTES = 8 * HTB, NXCD = 8, WGM = 8;

__host__ __device__ __forceinline__ int lds_byte(int r, int c) { const int st = (r >> 4) * 2 + (c >> 5), rr = r & 15, cc = c & 31, ob = rr * 64 + cc * 2; return st * 1024 + (ob ^ (((ob >> 9) & 1) << 5)); }
__host__ __device__ __forceinline__ void stage_rc(int b, int& R, int& C) { const int st = b / 1024, sb = b % 1024, swz = sb ^ (((sb >> 9) & 1) << 5); R = (st >> 1) * 16 + swz / 64; C = (st & 1) * 32 + (swz % 64) / 2; }
__host__ __device__ __forceinline__ int perm32(int rho) { const int n = rho >> 4, i = rho & 15; return 8 * (i >> 2) + 4 * n + (i & 3); }

struct Unit { int pm, pn, z; };
struct Gemm { const bf16_t* A; const bf16_t* Bt; int M, N, K; const bf16_t* A2; const bf16_t* Bt2; };

struct StaticOrder {
    int nM, nN, nwg, G, c;
    __host__ __device__ void init(int M, int N, int G_, int c_) { nM = M / BM; nN = N / BM; nwg = nM * nN; G = G_; c = c_; }
    __host__ __device__ bool next(int i, Unit& u) const {
        const long L = (long)i * G + c; if (L >= nwg) return false;
        int wgid = (int)L; { const int q = nwg / NXCD, r = nwg % NXCD, xcd = wgid % NXCD, off = wgid / NXCD; wgid = (xcd < r ? xcd * (q + 1) : r * (q + 1) + (xcd - r) * q) + off; }
        const int nig = WGM * nN, gid = wgid / nig, fm = gid * WGM, gsz = (nM - fm) < WGM ? (nM - fm) : WGM;
        u.pm = fm + ((wgid % nig) % gsz); u.pn = (wgid % nig) / gsz; u.z = 0; return true;
    }
    __device__ __forceinline__ void a_ready(const Unit&) const {}
    __device__ __forceinline__ void done(const Unit&) const {}
};


struct PairOrder {
    StaticOrder so;
    __host__ __device__ void init(int M, int N, int G_, int c_) { so.init(M, N, G_, c_); }
    __host__ __device__ bool next(int i, Unit& u) const { if (!so.next(i >> 1, u)) return false; u.z = i & 1; return true; }
    __device__ __forceinline__ void a_ready(const Unit&) const {}
    __device__ __forceinline__ void done(const Unit&) const {}
};

__device__ __forceinline__ unsigned f2bf_(float f) { unsigned u = __builtin_bit_cast(unsigned, f); return (u + 0x7fffu + ((u >> 16) & 1u)) >> 16; }
__device__ __forceinline__ unsigned pk2_(float lo, float hi) { return f2bf_(lo) | (f2bf_(hi) << 16); }
__device__ __forceinline__ u32x4 pack8(const f32x4 a, const f32x4 b) { u32x4 w; w.x = pk2_(a[0], a[1]); w.y = pk2_(a[2], a[3]); w.z = pk2_(b[0], b[1]); w.w = pk2_(b[2], b[3]); return w; }
__device__ __forceinline__ float silu_f(float x) { return x * __builtin_amdgcn_rcpf(1.f + __builtin_amdgcn_exp2f(-1.4426950408889634f * x)); }
__device__ __forceinline__ float sigm_f(float x) { return __builtin_amdgcn_rcpf(1.f + __builtin_amdgcn_exp2f(-1.4426950408889634f * x)); }
__device__ __forceinline__ f32x4 silu4(f32x4 v) { return (f32x4){silu_f(v[0]), silu_f(v[1]), silu_f(v[2]), silu_f(v[3])}; }
__device__ __forceinline__ f32x4 sigm4(f32x4 v) { return (f32x4){sigm_f(v[0]), sigm_f(v[1]), sigm_f(v[2]), sigm_f(v[3])}; }
constexpr float RMS_EPS = 1e-6f;
__device__ __forceinline__ float rstd_row(const float* ssq, int row) {
    const f32x4* p = (const f32x4*)(ssq + (size_t)row * 16); const f32x4 a = p[0], b = p[1], c = p[2], d = p[3];
    const float s = ((a[0] + a[1]) + (a[2] + a[3])) + ((b[0] + b[1]) + (b[2] + b[3])) + ((c[0] + c[1]) + (c[2] + c[3])) + ((d[0] + d[1]) + (d[2] + d[3]));
    return __builtin_amdgcn_rsqf(s * (1.0f / 1024.0f) + RMS_EPS);
}

struct EpiSwiglu {
    static constexpr bool PERM = true, AFTER_DRAIN = false;
    bf16_t* H; int ldh; const float* ssq;
    __device__ __forceinline__ bool keep(const Unit&) const { return false; }
    __device__ __forceinline__ void operator()(f32x4 (&acc)[2][2][4][2], const Unit& u, int wr, int wc, int fr, int fq) const {
        const int row0 = u.pm * BM + wr * 64 + fr, col0 = u.pn * HALF + wc * 32 + 8 * fq;
#pragma unroll
        for (int ai = 0; ai < 2; ++ai)
#pragma unroll
            for (int m = 0; m < 4; ++m) {
                const int row = row0 + ai * HALF + m * 16;
                const float rs = ssq ? rstd_row(ssq, row) : 1.f;
                const f32x4 g0 = acc[ai][0][m][0] * rs, g1 = acc[ai][0][m][1] * rs, u0 = acc[ai][1][m][0] * rs, u1 = acc[ai][1][m][1] * rs;
                *(u32x4*)(H + (size_t)row * ldh + col0) = pack8(silu4(g0) * u0, silu4(g1) * u1);
            }
    }
};

struct EpiResid {
    static constexpr bool PERM = true, AFTER_DRAIN = false;
    const float* base; float* out; const float* mbase; float* mout; float alpha; bf16_t* xn; const float* gain; float* ssq; int nreal;
    __device__ __forceinline__ bool keep(const Unit&) const { return false; }
    __device__ __forceinline__ void operator()(f32x4 (&acc)[2][2][4][2], const Unit& u, int wr, int wc, int fr, int fq) const {
        const int row0 = u.pm * BM + wr * 64 + fr, colb = u.pn * BM + wc * 32 + 8 * fq;
#pragma unroll
        for (int ai = 0; ai < 2; ++ai)
#pragma unroll
            for (int m = 0; m < 4; ++m) {
                const int row = row0 + ai * HALF + m * 16;
                const float* bp; float* op;
                if (row < nreal) { bp = base + (size_t)row * 1024; op = out + (size_t)row * 1024; }
                else if (mbase && row < nreal + 16) { bp = mbase + (size_t)(row - nreal) * 1024; op = mout + (size_t)(row - nreal) * 1024; }
                else continue;
                float ss = 0.f;
#pragma unroll
                for (int bj = 0; bj < 2; ++bj) {
                    const int col = colb + bj * HALF;
                    const f32x4 b0 = *(const f32x4*)(bp + col), b1 = *(const f32x4*)(bp + col + 4);
                    const f32x4 h0 = b0 + acc[ai][bj][m][0] * alpha, h1 = b1 + acc[ai][bj][m][1] * alpha;
                    *(f32x4*)(op + col) = h0; *(f32x4*)(op + col + 4) = h1;
                    ss += (h0[0] * h0[0] + h0[1] * h0[1]) + (h0[2] * h0[2] + h0[3] * h0[3]) + (h1[0] * h1[0] + h1[1] * h1[1]) + (h1[2] * h1[2] + h1[3] * h1[3]);
                    if (xn) { const f32x4 g0 = *(const f32x4*)(gain + col), g1 = *(const f32x4*)(gain + col + 4);
                        *(u32x4*)(xn + (size_t)row * 1024 + col) = pack8(h0 * g0, h1 * g1); }
                }
                ss += __shfl_xor(ss, 16); ss += __shfl_xor(ss, 32);
                if (fq == 0 && ssq) ssq[(size_t)row * 16 + u.pn * 4 + wc] = ss;
            }
    }
};

struct EpiWin {
    static constexpr bool PERM = true, AFTER_DRAIN = false;
    const float* ssq; int ct0;
    bf16_t *GQ, *GK, *GV, *GR, *IQ, *DQ, *DK, *DV, *GA, *GB, *IK; float* GLR; float* IW;
    __device__ __forceinline__ bool keep(const Unit&) const { return false; }
    __device__ __forceinline__ static size_t kvrow(int row) { return (size_t)(row >> 13) * 8320 + 16 + (row & 8191); }
    __device__ __forceinline__ void operator()(f32x4 (&acc)[2][2][4][2], const Unit& u, int wr, int wc, int fr, int fq) const {
        const int ct = ct0 + u.pn;
        bf16_t* P; int ld, cb, mode; float sc = 1.f;
        if (ct < 2)       { P = GQ; ld = 512;  cb = ct * 256;        mode = 0; sc = 0.08838834764831845f; }
        else if (ct < 4)  { P = GK; ld = 512;  cb = (ct - 2) * 256;  mode = 1; }
        else if (ct < 8)  { P = GV; ld = 1024; cb = (ct - 4) * 256;  mode = 1; }
        else if (ct < 12) { P = GR; ld = 1024; cb = (ct - 8) * 256;  mode = 2; }
        else if (ct < 14) { P = IQ; ld = 512;  cb = (ct - 12) * 256; mode = 0; }
        else if (ct == 14){ P = IK; ld = 64;   cb = 0;               mode = 5; }
        else if (ct < 19) { P = DQ; ld = 1024; cb = (ct - 15) * 256; mode = 0; sc = 0.08838834764831845f * 1.4426950408889634f; }
        else if (ct < 23) { P = DK; ld = 1024; cb = (ct - 19) * 256; mode = 4; }
        else if (ct < 27) { P = DV; ld = 1024; cb = (ct - 23) * 256; mode = 4; }
        else if (ct < 31) { P = GA; ld = 1024; cb = (ct - 27) * 256; mode = 3; }
        else              { P = GB; ld = 1024; cb = (ct - 31) * 256; mode = 3; }
        const int row0 = u.pm * BM + wr * 64 + fr, cl = wc * 32 + 8 * fq;
#pragma unroll
        for (int ai = 0; ai < 2; ++ai)
#pragma unroll
            for (int m = 0; m < 4; ++m) {
                const int row = row0 + ai * HALF + m * 16;
                if (row >= 16400) continue;
                const bool meta = row >= 16384;
                if (meta && (mode == 0 || mode == 2 || mode == 3)) continue;
                const float rs = rstd_row(ssq, row) * sc;
#pragma unroll
                for (int bj = 0; bj < 2; ++bj) {
                    f32x4 v0 = acc[ai][bj][m][0] * rs, v1 = acc[ai][bj][m][1] * rs;
                    const int c = bj * HALF + cl;
                    if (mode == 5) {
                        if (bj == 1 || c >= 88) continue;
                        if (c < 16) { float* g = GLR + (size_t)row * 16 + c; *(f32x4*)g = v0; *(f32x4*)(g + 4) = v1; }
                        else if (c < 80) { const u32x4 w = pack8(v0, v1);
                            if (!meta) *(u32x4*)(IK + kvrow(row) * 64 + (c - 16)) = w;
                            else { *(u32x4*)(IK + (size_t)(row - 16384) * 64 + (c - 16)) = w; *(u32x4*)(IK + (size_t)(8320 + row - 16384) * 64 + (c - 16)) = w; } }
                        else if (!meta) { const float s = 0.04419417382415922f; float* g = IW + (size_t)row * 8; *(f32x4*)g = v0 * s; *(f32x4*)(g + 4) = v1 * s; }
                        continue;
                    }
                    if (mode == 2) { v0 = silu4(v0); v1 = silu4(v1); }
                    if (mode == 3) { v0 = sigm4(v0); v1 = sigm4(v1); }
                    const u32x4 w = pack8(v0, v1);
                    if (mode == 4) {
                        if (!meta) *(u32x4*)(P + kvrow(row) * ld + cb + c) = w;
                        else { *(u32x4*)(P + (size_t)(row - 16384) * ld + cb + c) = w; *(u32x4*)(P + (size_t)(8320 + row - 16384) * ld + cb + c) = w; }
                    } else *(u32x4*)(P + (size_t)row * ld + cb + c) = w;
                }
            }
    }
};

struct EpiMerge {
    static constexpr bool PERM = true, AFTER_DRAIN = false;
    const bf16_t* GA; const bf16_t* GB; bf16_t* O;
    __device__ __forceinline__ bool keep(const Unit& u) const { return u.z == 0; }
    __device__ __forceinline__ static float bf(unsigned short x) { return __builtin_bit_cast(float, (unsigned)x << 16); }
    __device__ __forceinline__ void operator()(f32x4 (&acc)[2][2][4][2], const Unit& u, int wr, int wc, int fr, int fq) const {
        const int row0 = u.pm * BM + wr * 64 + fr, colb = u.pn * BM + wc * 32 + 8 * fq;
#pragma unroll
        for (int ai = 0; ai < 2; ++ai)
#pragma unroll
            for (int m = 0; m < 4; ++m) {
                const int row = row0 + ai * HALF + m * 16;
#pragma unroll
                for (int bj = 0; bj < 2; ++bj) {
                    const size_t off = (size_t)row * 1024 + colb + bj * HALF;
                    const bf16x8 sb = *(const bf16x8*)(GB + off);
                    if (u.z == 0) {
                        const bf16x8 sa = *(const bf16x8*)(GA + off);
#pragma unroll
                        for (int e = 0; e < 4; ++e) {
                            acc[ai][bj][m][0][e] *= bf((unsigned short)sa[e]) * __builtin_amdgcn_rcpf(bf((unsigned short)sb[e]));
                            acc[ai][bj][m][1][e] *= bf((unsigned short)sa[4 + e]) * __builtin_amdgcn_rcpf(bf((unsigned short)sb[4 + e]));
                        }
                    } else {
                        f32x4 v0, v1;
#pragma unroll
                        for (int e = 0; e < 4; ++e) { v0[e] = acc[ai][bj][m][0][e] * bf((unsigned short)sb[e]); v1[e] = acc[ai][bj][m][1][e] * bf((unsigned short)sb[4 + e]); }
                        *(u32x4*)(O + off) = pack8(v0, v1);
                    }
                }
            }
    }
};

template <class Epi, class Sched, bool ALIGN_EPI = false, bool SP2 = false>
__device__ __forceinline__ void gemm_phase(PG8_LAS unsigned char* lds, const Gemm g, const Sched& S, const Epi& E) {
    const int tid = threadIdx.x, wid = __builtin_amdgcn_readfirstlane(tid >> 6), lane = tid & 63, wr = wid >> 2, wc = wid & 3, fr = lane & 15, fq = lane >> 4;
    const int K = g.K, nt = K / BK;
    unsigned voffA[2], voffB[2];
#pragma unroll
    for (int i = 0; i < 2; ++i) { int R, C; stage_rc(tid * 16 + i * 8192, R, C); const int Rb = Epi::PERM ? ((R & ~31) + perm32(R & 31)) : R;
        voffA[i] = (unsigned)(R * K + C) * 2u; voffB[i] = (unsigned)(Rb * K + C) * 2u; }
    const size_t kstep = (size_t)(BK * 2);
    const size_t hstep = (size_t)HALF * K * 2;
    const size_t tstep = 2 * hstep;
    const unsigned ldsw = (unsigned)wid * 1024u;
    const int aoff = lds_byte(wr * 64 + fr, fq * 8), boff = lds_byte(wc * 32 + fr, fq * 8);
#define PG8_SA(b, h) (((b) * 2 + (h)) * HTB)
#define PG8_SB(b, h) ((4 + (b) * 2 + (h)) * HTB)
#define PG8_STAGE(bufoff, gbase, voff) do { _Pragma("unroll") for (int _i = 0; _i < 2; ++_i) \
        __builtin_amdgcn_global_load_lds((const unsigned*)((const char*)(gbase) + (voff)[_i]), (PG8_LAS unsigned*)(lds + (bufoff) + ldsw + _i * 8192), 16, 0, 0); } while (0)
#define PG8_LDA(dst, b, h) do { _Pragma("unroll") for (int m = 0; m < 4; ++m) _Pragma("unroll") for (int k = 0; k < 2; ++k) dst[m][k] = *(const PG8_LAS bf16x8*)(lds + PG8_SA(b, h) + aoff + m * 2048 + k * 1024); } while (0)
#define PG8_LDB(dst, b, h) do { _Pragma("unroll") for (int n = 0; n < 2; ++n) _Pragma("unroll") for (int k = 0; k < 2; ++k) dst[n][k] = *(const PG8_LAS bf16x8*)(lds + PG8_SB(b, h) + boff + n * 2048 + k * 1024); } while (0)
#define PG8_MMA(ai, bj, At, Bt) do { __builtin_amdgcn_s_setprio(1); _Pragma("unroll") for (int m = 0; m < 4; ++m) _Pragma("unroll") for (int n = 0; n < 2; ++n) _Pragma("unroll") for (int k = 0; k < 2; ++k) \
        acc[ai][bj][m][n] = __builtin_amdgcn_mfma_f32_16x16x32_bf16(Bt[n][k], At[m][k], acc[ai][bj][m][n], 0, 0, 0); __builtin_amdgcn_s_setprio(0); } while (0)
#define PG8_WAIT_V(n) asm volatile("s_waitcnt vmcnt(" #n ")" ::: "memory")
#define PG8_WAIT_L(n) asm volatile("s_waitcnt lgkmcnt(" #n ")" ::: "memory")
#define PG8_BAR __builtin_amdgcn_s_barrier()
#define PG8_SCHED __builtin_amdgcn_sched_barrier(0)
    Unit cur, nxt; int ui = 0;
    if (!S.next(0, cur)) return;
    f32x4 acc[2][2][4][2];
#pragma unroll
    for (int a = 0; a < 2; ++a)
#pragma unroll
        for (int b = 0; b < 2; ++b)
#pragma unroll
            for (int m = 0; m < 4; ++m)
#pragma unroll
                for (int n = 0; n < 2; ++n) acc[a][b][m][n] = (f32x4){0.f, 0.f, 0.f, 0.f};
    bf16x8 At[4][2], B0[2][2], B1[2][2];
    const char* cA = (const char*)(cur.z ? g.A2 : g.A) + (size_t)cur.pm * tstep; const char* cB = (const char*)(cur.z ? g.Bt2 : g.Bt) + (size_t)cur.pn * tstep;
    S.a_ready(cur);
    if constexpr (SP2) {
        PG8_STAGE(PG8_SB(0, 0), cB, voffB); PG8_STAGE(PG8_SB(0, 1), cB + hstep, voffB); PG8_STAGE(PG8_SA(0, 0), cA, voffA); PG8_STAGE(PG8_SA(0, 1), cA + hstep, voffA);
        if (wr == 1) PG8_BAR;
        PG8_WAIT_V(2); PG8_BAR;
        PG8_STAGE(PG8_SB(1, 0), cB + kstep, voffB); PG8_STAGE(PG8_SA(1, 0), cA + kstep, voffA); PG8_STAGE(PG8_SB(1, 1), cB + hstep + kstep, voffB);
        PG8_WAIT_V(6); PG8_BAR;
    } else {
        PG8_STAGE(PG8_SB(0, 0), cB, voffB); PG8_STAGE(PG8_SA(0, 0), cA, voffA); PG8_STAGE(PG8_SB(0, 1), cB + hstep, voffB); PG8_STAGE(PG8_SA(0, 1), cA + hstep, voffA);
        if (wr == 1) PG8_BAR;
        PG8_WAIT_V(4); PG8_BAR;
        PG8_STAGE(PG8_SB(1, 0), cB + kstep, voffB); PG8_STAGE(PG8_SA(1, 0), cA + kstep, voffA); PG8_STAGE(PG8_SB(1, 1), cB + hstep + kstep, voffB);
        PG8_WAIT_V(6); PG8_BAR;
    }
    for (;;) {
        const bool has_next = S.next(ui + 1, nxt);
        const char* nA = has_next ? (const char*)(nxt.z ? g.A2 : g.A) + (size_t)nxt.pm * tstep : cA; const char* nB = has_next ? (const char*)(nxt.z ? g.Bt2 : g.Bt) + (size_t)nxt.pn * tstep : cB;
        for (int t = 0; t < nt; t += 2) {
            const bool last = (t == nt - 2);
            const char* a1 = cA + (size_t)(t + 1) * kstep;
            const char* a2 = last ? nA : cA + (size_t)(t + 2) * kstep; const char* b2 = last ? nB : cB + (size_t)(t + 2) * kstep;
            const char* a3 = a2 + kstep; const char* b3 = b2 + kstep;
            if (last && has_next) S.a_ready(nxt);
            if constexpr (SP2) {
            PG8_LDB(B0, 0, 0); PG8_LDB(B1, 0, 1); PG8_SCHED; PG8_LDA(At, 0, 0); PG8_STAGE(PG8_SA(1, 1), a1 + hstep, voffA);
            PG8_WAIT_V(8); PG8_WAIT_L(0); PG8_BAR; PG8_MMA(0, 0, At, B0); PG8_MMA(0, 1, At, B1); PG8_BAR; PG8_SCHED;
            PG8_LDA(At, 0, 1); PG8_STAGE(PG8_SB(0, 0), b2, voffB); PG8_STAGE(PG8_SB(0, 1), b2 + hstep, voffB); PG8_STAGE(PG8_SA(0, 0), a2, voffA);
            PG8_WAIT_V(8); PG8_WAIT_L(0); PG8_BAR; PG8_MMA(1, 0, At, B0); PG8_MMA(1, 1, At, B1); PG8_BAR; PG8_SCHED;
            PG8_LDB(B0, 1, 0); PG8_LDB(B1, 1, 1); PG8_SCHED; PG8_LDA(At, 1, 0); PG8_STAGE(PG8_SA(0, 1), a2 + hstep, voffA);
            PG8_WAIT_V(8); PG8_WAIT_L(0); PG8_BAR; PG8_MMA(0, 0, At, B0); PG8_MMA(0, 1, At, B1); PG8_BAR; PG8_SCHED;
            PG8_LDA(At, 1, 1); PG8_STAGE(PG8_SB(1, 0), b3, voffB); PG8_STAGE(PG8_SB(1, 1), b3 + hstep, voffB); PG8_STAGE(PG8_SA(1, 0), a3, voffA);
            PG8_WAIT_V(8); PG8_WAIT_L(0); PG8_BAR; PG8_MMA(1, 0, At, B0); PG8_MMA(1, 1, At, B1); PG8_BAR; PG8_SCHED;
            } else {
            PG8_LDB(B0, 0, 0); PG8_SCHED; PG8_LDA(At, 0, 0); PG8_STAGE(PG8_SA(1, 1), a1 + hstep, voffA);
            PG8_WAIT_L(8); PG8_BAR; PG8_WAIT_L(0); PG8_MMA(0, 0, At, B0); PG8_BAR; PG8_SCHED;
            PG8_LDB(B1, 0, 1); PG8_STAGE(PG8_SB(0, 0), b2, voffB);
            PG8_BAR; PG8_WAIT_L(0); PG8_MMA(0, 1, At, B1); PG8_BAR;
            PG8_LDA(At, 0, 1); PG8_STAGE(PG8_SA(0, 0), a2, voffA);
            PG8_BAR; PG8_WAIT_L(0); PG8_MMA(1, 0, At, B0); PG8_BAR; PG8_SCHED;
            PG8_STAGE(PG8_SB(0, 1), b2 + hstep, voffB);
            PG8_WAIT_V(6); PG8_BAR; PG8_MMA(1, 1, At, B1); PG8_BAR;
            PG8_LDB(B0, 1, 0); PG8_SCHED; PG8_LDA(At, 1, 0); PG8_STAGE(PG8_SA(0, 1), a2 + hstep, voffA);
            PG8_WAIT_L(8); PG8_BAR; PG8_WAIT_L(0); PG8_MMA(0, 0, At, B0); PG8_BAR; PG8_SCHED;
            PG8_LDB(B1, 1, 1); PG8_STAGE(PG8_SB(1, 0), b3, voffB);
            PG8_BAR; PG8_WAIT_L(0); PG8_MMA(0, 1, At, B1); PG8_BAR;
            PG8_LDA(At, 1, 1); PG8_STAGE(PG8_SA(1, 0), a3, voffA);
            PG8_BAR; PG8_WAIT_L(0); PG8_MMA(1, 0, At, B0); PG8_BAR; PG8_SCHED;
            PG8_STAGE(PG8_SB(1, 1), b3 + hstep, voffB);
            PG8_WAIT_V(6); PG8_BAR; PG8_MMA(1, 1, At, B1); PG8_BAR;
            }
        }
        if constexpr (ALIGN_EPI) { if (wr == 0) PG8_BAR; }
        if constexpr (!Epi::AFTER_DRAIN) { E(acc, cur, wr, wc, fr, fq); S.done(cur); }
        if (!has_next) break;
        if (!E.keep(cur)) {
#pragma unroll
        for (int a = 0; a < 2; ++a)
#pragma unroll
            for (int b = 0; b < 2; ++b)
#pragma unroll
                for (int m = 0; m < 4; ++m)
#pragma unroll
                    for (int n = 0; n < 2; ++n) acc[a][b][m][n] = (f32x4){0.f, 0.f, 0.f, 0.f};
        }
        cur = nxt; cA = nA; cB = nB; ++ui;
        if constexpr (ALIGN_EPI) { if (wr == 1) PG8_BAR; }
    }
    PG8_WAIT_V(0);
    if constexpr (!ALIGN_EPI) { if (wr == 0) PG8_BAR; }
    PG8_BAR;
    if constexpr (Epi::AFTER_DRAIN) { E.fused(acc, cur, wr, wc, fr, fq, lds, wid, lane); S.done(cur); }
#undef PG8_SA
#undef PG8_SB
#undef PG8_STAGE
#undef PG8_LDA
#undef PG8_LDB
#undef PG8_MMA
#undef PG8_WAIT_V
#undef PG8_WAIT_L
#undef PG8_BAR
#undef PG8_SCHED
}
}

#define GAS __attribute__((address_space(1)))
#define LAS __attribute__((address_space(3)))
typedef unsigned short bf16;
typedef unsigned v4u __attribute__((ext_vector_type(4)));
typedef float f32x4 __attribute__((ext_vector_type(4)));
typedef short bf16x8 __attribute__((ext_vector_type(8)));
typedef GAS unsigned gu32;
typedef GAS unsigned long long gu64;
#define RLX_AGENT __ATOMIC_RELAXED, __HIP_MEMORY_SCOPE_AGENT
#define LDS_WAIT() asm volatile("s_waitcnt lgkmcnt(0)" ::: "memory")
#define VM_WAIT() asm volatile("s_waitcnt vmcnt(0)" ::: "memory")
__device__ __forceinline__ unsigned long long rt() { return __builtin_amdgcn_s_memrealtime(); }
__device__ __forceinline__ unsigned f2bf(float f) { unsigned u = __builtin_bit_cast(unsigned, f); return (u + 0x7fffu + ((u >> 16) & 1u)) >> 16; }
__device__ __forceinline__ unsigned pk2(float lo, float hi) { return f2bf(lo) | (f2bf(hi) << 16); }

#define XB_TMO      128
#define XB_XCNT(j)  (256  + 64 * (j))
#define XB_XSUB(j)  (1280 + 64 * (j))
#define XB_XGEN(j)  (2304 + 64 * (j))
#define XB_TOP      3328
#define XB_TOPGEN   3392
#define XCD_BAR_WORDS 3456
#define XB_SPIN_CAP (1u << 25)

__device__ __forceinline__ unsigned xb_ld(unsigned* p)              { return __hip_atomic_load(p, __ATOMIC_RELAXED, __HIP_MEMORY_SCOPE_AGENT); }
__device__ __forceinline__ unsigned xb_add(unsigned* p, unsigned v) { return __hip_atomic_fetch_add(p, v, __ATOMIC_RELAXED, __HIP_MEMORY_SCOPE_AGENT); }
__device__ __forceinline__ unsigned xb_xcc_id() { return (unsigned)__builtin_amdgcn_s_getreg((3 << 11) | 20) & 0xFu; }
#define XB_SPIN(cond, bar) do { unsigned _sp = 0; while (cond) { __builtin_amdgcn_s_sleep(1); \
    if ((++_sp & 255u) == 0u) { if (xb_ld(&(bar)[XB_TMO])) break; if (_sp > XB_SPIN_CAP) { atomicAdd(&(bar)[XB_TMO], 1u); break; } } } } while (0)

struct XcdBarrier {
    unsigned* bar; unsigned x;
    volatile LAS unsigned* st;
};

__device__ __forceinline__ XcdBarrier xcd_barrier_post(unsigned* bar, volatile LAS unsigned* st) {
    XcdBarrier b; b.bar = bar; b.x = xb_xcc_id(); b.st = st;
    if (threadIdx.x == 0) (void)xb_add(&bar[XB_XCNT(b.x)], 1u);
    return b;
}
__device__ __forceinline__ void xcd_barrier_complete(unsigned* bar, unsigned x, unsigned& nloc, unsigned& nx) {
    const unsigned G = gridDim.x * gridDim.y * gridDim.z;
    unsigned sum, cnt, mine, sp = 0u;
    for (;;) {
        sum = 0u; cnt = 0u; mine = 0u;
#pragma unroll
        for (unsigned j = 0; j < 16; ++j) { const unsigned c = xb_ld(&bar[XB_XCNT(j)]); sum += c; cnt += (c > 0u) ? 1u : 0u; mine = (j == x) ? c : mine; }
        if (sum == G) break;
        __builtin_amdgcn_s_sleep(1);
        if ((++sp & 255u) == 0u) { if (xb_ld(&bar[XB_TMO])) break; if (sp > XB_SPIN_CAP) { atomicAdd(&bar[XB_TMO], 1u); break; } }
    }
    nloc = mine > 0u ? mine : 1u; nx = cnt > 0u ? cnt : 1u;
}

__device__ __forceinline__ void xcd_barrier(const XcdBarrier& b) {
    asm volatile("s_waitcnt vmcnt(0)" ::: "memory");
    __syncthreads();
    if (threadIdx.x == 0) {
        unsigned* bar = b.bar;
        __builtin_amdgcn_s_waitcnt(0);
        unsigned nloc = b.st[0], nx = b.st[1];
        if (nloc == 0u) { xcd_barrier_complete(bar, b.x, nloc, nx); b.st[0] = nloc; b.st[1] = nx; }
        const unsigned old = xb_add(&bar[XB_XSUB(b.x)], 1u);
        const unsigned gen = old / nloc;
        if (old + 1u == (gen + 1u) * nloc) {
            __builtin_amdgcn_fence(__ATOMIC_RELEASE, "agent");
            asm volatile("s_waitcnt vmcnt(0)" ::: "memory");
            const unsigned og = xb_add(&bar[XB_TOP], 1u);
            const unsigned tg = og / nx;
            if (og + 1u == (tg + 1u) * nx) xb_add(&bar[XB_TOPGEN], 1u);
            else XB_SPIN(xb_ld(&bar[XB_TOPGEN]) == tg, bar);
            __builtin_amdgcn_fence(__ATOMIC_ACQUIRE, "agent");
            xb_add(&bar[XB_XGEN(b.x)], 1u);
            asm volatile("s_waitcnt vmcnt(0)" ::: "memory");
        } else {
            XB_SPIN(xb_ld(&bar[XB_XGEN(b.x)]) == gen, bar);
            __builtin_amdgcn_fence(__ATOMIC_ACQUIRE, "agent");
            asm volatile("s_waitcnt vmcnt(0)" ::: "memory");
        }
    }
    __syncthreads();
}


constexpr int NWAVES = 8;
constexpr int DM = 1024, DFF = 2816, NREAL = 16384, NROWS = 16640  , TSEQ = 8192, NMETA = 16, KVR = 8320  ;
constexpr int NCT_WIN = 35;
constexpr int MASKW = 260;
constexpr size_t MiB = 1u << 20, QMiB = 1u << 18;
constexpr size_t WS_CTL = 0, CTL_ZERO_BYTES = 1 * MiB;
constexpr size_t WS_SSQA = 4 * QMiB, WS_SSQB = 9 * QMiB, WS_SSQC = 14 * QMiB, WS_METAH = 19 * QMiB, WS_BIAST = 19 * QMiB + 65536, WS_GLR = 20 * QMiB, WS_IW = 25 * QMiB, WS_DBUF = 27 * QMiB;
constexpr size_t WS_W1GU = 8 * MiB, WS_W1D = 19 * MiB, WS_WIN = 98 * QMiB, WS_WA = 42 * MiB, WS_WB = 44 * MiB, WS_WO = 46 * MiB, WS_W2GU = 48 * MiB, WS_W2D = 59 * MiB;
constexpr size_t WS_MASK = 8 * MiB;
constexpr size_t WS_XN = 65 * MiB;
constexpr size_t WS_HB = 98 * MiB;
constexpr size_t WS_GQ = 98 * MiB, WS_GK = 114 * MiB, WS_GV = 521 * QMiB, WS_GR = 651 * QMiB, WS_LBUF = 195 * MiB, WS_TT = 212 * MiB, WS_IKB = 227 * MiB, WS_IQ = 230 * MiB;
constexpr size_t WS_DQ = 98 * MiB, WS_DKB = 130 * MiB, WS_DVB = 212 * MiB;
constexpr size_t WS_GA = 130 * MiB, WS_GB = 212 * MiB;
constexpr size_t WS_A3 = 98 * MiB, WS_HB2 = 130 * MiB;
constexpr size_t WS_END = 256 * MiB;
static_assert(WS_WIN + (size_t)NCT_WIN * 256 * 1024 * 2 <= WS_WA && WS_W2D + (size_t)1024 * DFF * 2 <= WS_XN && WS_XN + (size_t)NROWS * 1024 * 2 <= WS_HB, "ws map 1");
static_assert(WS_HB + (size_t)NROWS * DFF * 2 <= WS_END && WS_GR + (size_t)NREAL * 1024 * 2 <= WS_LBUF && WS_GV + (size_t)NROWS * 1024 * 2 <= WS_GR && WS_GK + (size_t)NROWS * 512 * 2 <= WS_GV, "ws map 2");
static_assert(WS_LBUF + (size_t)132 * 131072 <= WS_TT && WS_TT + (size_t)128 * 65536 <= WS_IKB && WS_IKB + (size_t)2 * KVR * 64 * 2 <= WS_IQ && WS_IQ + (size_t)NREAL * 512 * 2 <= WS_END, "ws map 3");
static_assert(WS_DKB + (size_t)2 * KVR * 1024 * 2 <= WS_GR && WS_DVB + (size_t)2 * KVR * 1024 * 2 <= WS_END && WS_MASK + (size_t)NREAL * MASKW * 4 <= WS_WIN && WS_HB2 + (size_t)NREAL * DFF * 2 <= WS_END, "ws map 4");
static_assert(WS_SSQA + (size_t)NROWS * 64 <= WS_SSQB && WS_SSQB + (size_t)NROWS * 64 <= WS_SSQC && WS_SSQC + (size_t)NROWS * 64 <= WS_METAH && WS_GLR + (size_t)NROWS * 64 <= WS_IW && WS_IW + (size_t)NREAL * 32 <= WS_DBUF && WS_DBUF + 132 * 512 <= WS_W1GU, "ws map 5");
constexpr int CW_TMO = 0, CW_CODE = 1, CW_BAR = 4096, CW_QUEUE = 16384;

constexpr int RING_OFF = 0, RING_BYTES = 131072;
constexpr int LDSCTL_OFF = RING_BYTES, MISC_OFF = LDSCTL_OFF + 320;
constexpr int LDS_BYTES = 147456;

struct Frame {
    LAS unsigned char* lds;
    volatile LAS unsigned* MISC;
    gu32* ctl;
    int tid, lane, wave, vcu, G;
    unsigned char* ws;
    const float *x, *meta, *n1, *w1g, *w1u, *w1d, *nm, *win, *wlr, *blr, *gn, *wa, *wb, *wo, *rb, *n2, *w2g, *w2u, *w2d, *nf;
    float* out;
};
__device__ __forceinline__ float wave_sum(float v) {
#pragma unroll
    for (int o = 1; o < 64; o <<= 1) v += __shfl_xor(v, o);
    return v;
}
__device__ __forceinline__ float bf2f(unsigned short x) { return __builtin_bit_cast(float, (unsigned)x << 16); }


template <class F>
__device__ __forceinline__ void p0_transpose_item(const float* W, int Nsrc, int K, bf16* WT, int nblk, LAS float* scr, int item, int lane, F srccol) {
    const int kb = item / nblk, nb = item % nblk, k0 = 64 * kb, n0 = 32 * nb;
    const int sc = srccol(n0 + (lane & 31));
#pragma unroll 8
    for (int i = 0; i < 32; ++i) { const int kk = 2 * i + (lane >> 5); scr[kk * 33 + (lane & 31)] = sc >= 0 ? W[(size_t)(k0 + kk) * Nsrc + sc] : 0.f; }
    LDS_WAIT(); asm volatile("" ::: "memory");
    const int c = lane & 7;
#pragma unroll
    for (int j = 0; j < 4; ++j) { const int n = (lane >> 3) + 8 * j; const LAS float* s = scr + (8 * c) * 33 + n;
        v4u o; o.x = pk2(s[0 * 33], s[1 * 33]); o.y = pk2(s[2 * 33], s[3 * 33]); o.z = pk2(s[4 * 33], s[5 * 33]); o.w = pk2(s[6 * 33], s[7 * 33]);
        *(GAS v4u*)(WT + (size_t)(n0 + n) * K + k0 + 8 * c) = o; }
    LDS_WAIT(); asm volatile("" ::: "memory");
}
__device__ __forceinline__ int win_src(int n) {
    const int ct = n >> 8, r = n & 255;
    if (ct < 2) return 0 + (ct - 0) * 256 + r;
    if (ct < 4) return 512 + (ct - 2) * 256 + r;
    if (ct < 8) return 1024 + (ct - 4) * 256 + r;
    if (ct < 12) return 2048 + (ct - 8) * 256 + r;
    if (ct < 14) return 6160 + (ct - 12) * 256 + r;
    if (ct == 14) return r < 16 ? 3072 + r : (r < 80 ? 6672 + (r - 16) : (r < 88 ? 6736 + (r - 80) : -1));
    if (ct < 19) return 3088 + (ct - 15) * 256 + r;
    if (ct < 23) return 4112 + (ct - 19) * 256 + r;
    if (ct < 27) return 5136 + (ct - 23) * 256 + r;
    if (ct < 31) return 6744 + (ct - 27) * 256 + r;
    return 7768 + (ct - 31) * 256 + r;
}
__device__ __forceinline__ void rms_row_to_bf16(const float* xrow, const float* gain, bf16* orow, int lane) {
    const GAS f32x4* xr = (const GAS f32x4*)xrow + lane; const GAS f32x4* gr = (const GAS f32x4*)gain + lane;
    f32x4 v[4]; float s = 0.f;
#pragma unroll
    for (int j = 0; j < 4; ++j) { v[j] = xr[64 * j]; s += (v[j].x * v[j].x + v[j].y * v[j].y) + (v[j].z * v[j].z + v[j].w * v[j].w); }
    const float rstd = 1.f / sqrtf(wave_sum(s) * (1.f / 1024.f) + 1e-6f);
    GAS unsigned long long* o8 = (GAS unsigned long long*)orow + lane;
#pragma unroll
    for (int j = 0; j < 4; ++j) { const f32x4 g = gr[64 * j];
        o8[64 * j] = (unsigned long long)pk2(v[j].x * rstd * g.x, v[j].y * rstd * g.y) | ((unsigned long long)pk2(v[j].z * rstd * g.z, v[j].w * rstd * g.w) << 32); }
}
__device__ __forceinline__ int rel_bucket_dev(int n) {
    if (n < 16) return n;
    const float nf = (float)n;
    int large = 16 + (int)(logf(nf / 16.0f) / 2.0794415416798357f * 16.0f);
    return large < 31 ? large : 31;
}
__device__ __forceinline__ void p0_prologue(Frame& F) {
    LAS float* scr = (LAS float*)(F.lds + RING_OFF + F.wave * 16384);
    const int gw = F.vcu * NWAVES + F.wave, NGW = F.G * NWAVES;
    unsigned char* ws = F.ws;
    constexpr int I_GU = (1024 / 64) * (5632 / 32), I_D = (2816 / 64) * (1024 / 32), I_WIN = (1024 / 64) * (NCT_WIN * 256 / 32), I_SQ = (1024 / 64) * (1024 / 32);
    constexpr int NITEMS = 2 * I_GU + 2 * I_D + I_WIN + 3 * I_SQ;
    for (int it = gw; it < NITEMS; it += NGW) {
        int r = it;
        if (r < I_GU) { const float* g = F.w1g; const float* u = F.w1u; const int nb = r % (5632 / 32); const bool up = ((nb * 32) & 128) != 0;
            p0_transpose_item(up ? u : g, DFF, 1024, (bf16*)(ws + WS_W1GU), 5632 / 32, scr, r, F.lane, [](int n) { return (n >> 8) * 128 + (n & 127); }); continue; } r -= I_GU;
        if (r < I_GU) { const float* g = F.w2g; const float* u = F.w2u; const int nb = r % (5632 / 32); const bool up = ((nb * 32) & 128) != 0;
            p0_transpose_item(up ? u : g, DFF, 1024, (bf16*)(ws + WS_W2GU), 5632 / 32, scr, r, F.lane, [](int n) { return (n >> 8) * 128 + (n & 127); }); continue; } r -= I_GU;
        if (r < I_D) { p0_transpose_item(F.w1d, 1024, DFF, (bf16*)(ws + WS_W1D), 1024 / 32, scr, r, F.lane, [](int n) { return n; }); continue; } r -= I_D;
        if (r < I_D) { p0_transpose_item(F.w2d, 1024, DFF, (bf16*)(ws + WS_W2D), 1024 / 32, scr, r, F.lane, [](int n) { return n; }); continue; } r -= I_D;
        if (r < I_WIN) { p0_transpose_item(F.win, 8792, 1024, (bf16*)(ws + WS_WIN), NCT_WIN * 256 / 32, scr, r, F.lane, [](int n) { return win_src(n); }); continue; } r -= I_WIN;
        if (r < I_SQ) { p0_transpose_item(F.wa, 1024, 1024, (bf16*)(ws + WS_WA), 32, scr, r, F.lane, [](int n) { return n; }); continue; } r -= I_SQ;
        if (r < I_SQ) { p0_transpose_item(F.wb, 1024, 1024, (bf16*)(ws + WS_WB), 32, scr, r, F.lane, [](int n) { return n; }); continue; } r -= I_SQ;
        p0_transpose_item(F.wo, 1024, 1024, (bf16*)(ws + WS_WO), 32, scr, r, F.lane, [](int n) { return n; });
    }
    bf16* XN = (bf16*)(ws + WS_XN);
    for (int m = gw; m < NREAL + NMETA; m += NGW)
        rms_row_to_bf16(m < NREAL ? F.x + (size_t)m * DM : F.meta + (size_t)(m - NREAL) * DM, F.n1, XN + (size_t)m * DM, F.lane);
    if (blockIdx.x == 0) {
        float* bt = (float*)(ws + WS_BIAST);
        for (int i = F.tid; i < 8 * 128; i += NWAVES * 64) { const int h = i >> 7, d = i & 127; bt[i] = (F.rb[rel_bucket_dev(d) * 8 + h] - F.rb[31 * 8 + h]) * 1.4426950408889634f; }
    }
}
__device__ __forceinline__ void p_final(Frame& F, const float* ssq) {
    const int gw = F.vcu * NWAVES + F.wave, NGW = F.G * NWAVES;
    for (int m = gw; m < NREAL; m += NGW) {
        const float rs = pg8::rstd_row(ssq, m);
        GAS f32x4* xr = (GAS f32x4*)(F.out + (size_t)m * DM) + F.lane; const GAS f32x4* gr = (const GAS f32x4*)F.nf + F.lane;
#pragma unroll
        for (int j = 0; j < 4; ++j) { const f32x4 v = xr[64 * j], g = gr[64 * j]; xr[64 * j] = v * rs * g; }
    }
}


typedef short s16x8 __attribute__((ext_vector_type(8)));
typedef short s16x4v __attribute__((ext_vector_type(4)));
typedef float f32x16 __attribute__((ext_vector_type(16)));
typedef unsigned u32x2 __attribute__((ext_vector_type(2)));
__device__ __forceinline__ int crow16(int r, int hi) { return (r & 3) + 8 * (r >> 2) + 4 * hi; }
__device__ __forceinline__ s16x4v ldtr(const LAS unsigned char* p) { return __builtin_bit_cast(s16x4v, __builtin_amdgcn_ds_read_tr16_b64_v4i16((LAS s16x4v*)p)); }
__device__ __forceinline__ s16x8 cat8(s16x4v a, s16x4v b) { return (s16x8){a[0], a[1], a[2], a[3], b[0], b[1], b[2], b[3]}; }
__device__ __forceinline__ float logsigmoid_f(float x) { return fminf(x, 0.f) - __logf(1.f + __expf(-fabsf(x))); }

constexpr int GLA_QT = 0, GLA_KT = 17408, GLA_VS = 34816, GLA_AM = 68608, GLA_EBL = 77824, GLA_GLR = 78336, GLA_PART = 82432;
constexpr int PQ = 272, PV = 528, PA = 144;

__device__ __forceinline__ void gla_phase_a(Frame& F) {
    unsigned char* ws = F.ws;
    bf16* GQ = (bf16*)(ws + WS_GQ); bf16* GK = (bf16*)(ws + WS_GK); bf16* GV = (bf16*)(ws + WS_GV);
    const float* GLR = (const float*)(ws + WS_GLR); float* LBUF = (float*)(ws + WS_LBUF); float* DBUF = (float*)(ws + WS_DBUF);
    LAS unsigned char* L = F.lds + RING_OFF;
    const int tid = F.tid, lane = F.lane, w = F.wave, hi = lane >> 5, l31 = lane & 31;
    const int d = tid & 127, tg = tid >> 7;
    for (int u = F.vcu; u < 132; u += F.G) {
        const bool meta = u >= 128;
        const int b = meta ? 0 : (u >> 6), h = meta ? (u - 128) : ((u >> 4) & 3), j = meta ? 0 : (u & 15);
        const float bl = F.blr[128 * h + d];
        float Bsup = 0.f;
        f32x16 S[4];
#pragma unroll
        for (int dt = 0; dt < 4; ++dt) S[dt] = (f32x16){};
        const int nch = meta ? 1 : 8, ntok = meta ? 16 : 64;
        for (int c = 0; c < nch; ++c) {
            const int row0 = meta ? NREAL : (b * TSEQ + 512 * j + 64 * c);
            { LAS float* gs = (LAS float*)(L + GLA_GLR);
              for (int i = tid; i < 64 * 16; i += 512) { const int t = i >> 4; gs[i] = t < ntok ? GLR[(size_t)(row0 + t) * 16 + (i & 15)] : 0.f; }
              const int vr = tid >> 3, seg = tid & 7;
#pragma unroll
              for (int q4 = 0; q4 < 4; ++q4) { v4u x = (v4u){0u, 0u, 0u, 0u}; if (vr < ntok) x = *(const v4u*)(GV + (size_t)(row0 + vr) * 1024 + 256 * h + 32 * seg + 8 * q4);
                  *(LAS v4u*)(L + GLA_VS + vr * PV + (32 * seg + 8 * q4) * 2) = x; } }
            __syncthreads();
            float cs[16]; float run = 0.f;
            { float wl[16];
#pragma unroll
              for (int i = 0; i < 16; ++i) wl[i] = F.wlr[i * 512 + 128 * h + d];
              asm volatile("" ::: "memory");
              const LAS float* gs = (const LAS float*)(L + GLA_GLR);
#pragma unroll
              for (int tt = 0; tt < 16; ++tt) { const int t = 16 * tg + tt; float x = bl;
#pragma unroll
                  for (int i = 0; i < 16; ++i) x += gs[t * 16 + i] * wl[i];
                  const float g = (t < ntok) ? logsigmoid_f(x) * (1.0f / 16.0f) : 0.f; run += g; cs[tt] = run; } }
            ((LAS float*)(L + GLA_PART))[tg * 128 + d] = run;
            __syncthreads();
            float pre = 0.f, tot = 0.f;
#pragma unroll
            for (int g4 = 0; g4 < 4; ++g4) { const float pv = ((const LAS float*)(L + GLA_PART))[g4 * 128 + d]; tot += pv; if (g4 < tg) pre += pv; }
            const float esup = __expf(Bsup);
#pragma unroll
            for (int tt = 0; tt < 16; ++tt) { const int t = 16 * tg + tt; const float bb = pre + cs[tt];
                float qv = 0.f, kv = 0.f;
                if (t < ntok) { kv = bf2f(GK[(size_t)(row0 + t) * 512 + 128 * h + d]); if (!meta) qv = bf2f(GQ[(size_t)(row0 + t) * 512 + 128 * h + d]); }
                const float qt = qv * __expf(bb), kt = kv * __expf(-bb);
                *(LAS unsigned short*)(L + GLA_QT + t * PQ + d * 2) = (unsigned short)f2bf(qt);
                *(LAS unsigned short*)(L + GLA_KT + t * PQ + d * 2) = (unsigned short)f2bf(kt);
                if (!meta) GQ[(size_t)(row0 + t) * 512 + 128 * h + d] = (bf16)f2bf(qt * esup); }
            if (tg == 0) ((LAS float*)(L + GLA_EBL))[d] = __expf(tot);
            Bsup += tot;
            __syncthreads();
            if (w < 3) {
                const int ti = w ? 1 : 0, si = (w == 2) ? 1 : 0;
                f32x16 a = (f32x16){};
#pragma unroll
                for (int ks = 0; ks < 8; ++ks) {
                    const s16x8 ka = *(const LAS s16x8*)(L + GLA_KT + (32 * si + l31) * PQ + (16 * ks + 8 * hi) * 2);
                    const s16x8 qb = *(const LAS s16x8*)(L + GLA_QT + (32 * ti + l31) * PQ + (16 * ks + 8 * hi) * 2);
                    a = __builtin_amdgcn_mfma_f32_32x32x16_bf16(ka, qb, a, 0, 0, 0);
                }
                const int t = 32 * ti + l31;
#pragma unroll
                for (int g4 = 0; g4 < 4; ++g4) { const int s0 = 32 * si + 8 * g4 + 4 * hi;
                    float v0 = a[4 * g4 + 0], v1 = a[4 * g4 + 1], v2 = a[4 * g4 + 2], v3 = a[4 * g4 + 3];
                    if (s0 + 0 > t) v0 = 0.f; if (s0 + 1 > t) v1 = 0.f; if (s0 + 2 > t) v2 = 0.f; if (s0 + 3 > t) v3 = 0.f;
                    *(LAS u32x2*)(L + GLA_AM + t * PA + s0 * 2) = (u32x2){pk2(v0, v1), pk2(v2, v3)}; }
            } else if (w == 3) {
                const int t = l31;
#pragma unroll
                for (int g4 = 0; g4 < 4; ++g4) *(LAS u32x2*)(L + GLA_AM + t * PA + (32 + 8 * g4 + 4 * hi) * 2) = (u32x2){0u, 0u};
            }
            __syncthreads();
            const int g1 = (lane >> 4) & 1, q = (lane & 15) >> 2, p = lane & 3;
            s16x8 vf[4];
#pragma unroll
            for (int ks = 0; ks < 4; ++ks) { const LAS unsigned char* vp = L + GLA_VS + (16 * ks + 8 * hi + q) * PV + (32 * w + 16 * g1 + 4 * p) * 2;
                vf[ks] = cat8(ldtr(vp), ldtr(vp + 4 * PV)); }
            if (!meta) {
#pragma unroll 1
                for (int ti = 0; ti < 2; ++ti) {
                    f32x16 o = (f32x16){};
                    const int t = 32 * ti + l31;
#pragma unroll
                    for (int ks = 0; ks < 4; ++ks) { const s16x8 af = *(const LAS s16x8*)(L + GLA_AM + t * PA + (16 * ks + 8 * hi) * 2);
                        o = __builtin_amdgcn_mfma_f32_32x32x16_bf16(af, vf[ks], o, 0, 0, 0); }
#pragma unroll
                    for (int dt = 0; dt < 4; ++dt) {
#pragma unroll
                        for (int s2 = 0; s2 < 2; ++s2) { const LAS unsigned char* qp = L + GLA_QT + t * PQ + (32 * dt + 16 * s2 + 4 * hi) * 2;
                            const s16x4v q0 = *(const LAS s16x4v*)qp, q1 = *(const LAS s16x4v*)(qp + 16);
                            v4u x; x.x = pk2(S[dt][8 * s2 + 0], S[dt][8 * s2 + 1]); x.y = pk2(S[dt][8 * s2 + 2], S[dt][8 * s2 + 3]); x.z = pk2(S[dt][8 * s2 + 4], S[dt][8 * s2 + 5]); x.w = pk2(S[dt][8 * s2 + 6], S[dt][8 * s2 + 7]);
                            o = __builtin_amdgcn_mfma_f32_32x32x16_bf16(cat8(q0, q1), __builtin_bit_cast(s16x8, x), o, 0, 0, 0); }
                        __builtin_amdgcn_sched_barrier(0);
                    }
                    { bf16* op = GV + (size_t)(row0 + 32 * ti + 4 * hi) * 1024 + 256 * h + 32 * w + l31; asm volatile("" : "+v"(op));
#pragma unroll
                      for (int r = 0; r < 16; ++r) op[((r & 3) + 8 * (r >> 2)) * 1024] = (bf16)f2bf(o[r]); }
                }
            }
            __builtin_amdgcn_sched_barrier(0);
#pragma unroll
            for (int dt = 0; dt < 4; ++dt) {
#pragma unroll
                for (int ks = 0; ks < 4; ++ks) { const LAS unsigned char* kp = L + GLA_KT + (16 * ks + 8 * hi + q) * PQ + (32 * dt + 16 * g1 + 4 * p) * 2;
                    const s16x8 kf = cat8(ldtr(kp), ldtr(kp + 4 * PQ));
                    S[dt] = __builtin_amdgcn_mfma_f32_32x32x16_bf16(kf, vf[ks], S[dt], 0, 0, 0); }
#pragma unroll
                for (int r = 0; r < 16; ++r) S[dt][r] *= ((const LAS float*)(L + GLA_EBL))[32 * dt + crow16(r, hi)];
                __builtin_amdgcn_sched_barrier(0);
            }
            __syncthreads();
        }
        float* Lu = LBUF + (size_t)u * 32768 + (4 * hi) * 256 + 32 * w + l31;
#pragma unroll
        for (int dt = 0; dt < 4; ++dt) { asm volatile("" : "+v"(Lu));
#pragma unroll
            for (int r = 0; r < 16; ++r) Lu[((r & 3) + 8 * (r >> 2)) * 256] = S[dt][r];
            Lu += 32 * 256; }
        if (tg == 0) DBUF[u * 128 + d] = __expf(Bsup);
    }
}

__device__ __forceinline__ void gla_phase_b(Frame& F) {
    unsigned char* ws = F.ws;
    const float* LBUF = (const float*)(ws + WS_LBUF); const float* DBUF = (const float*)(ws + WS_DBUF); bf16* TT = (bf16*)(ws + WS_TT);
    const int gt = F.vcu * (NWAVES * 64) + F.tid, NT = F.G * NWAVES * 64;
    for (int e = gt; e < 8 * 32768; e += NT) {
        const int bh = e >> 15, idx = e & 32767, dd = idx >> 8, h = bh & 3;
        float T = LBUF[(size_t)(128 + h) * 32768 + idx];
        for (int j = 0; j < 16; ++j) { const int u = bh * 16 + j;
            TT[(size_t)u * 32768 + idx] = (bf16)f2bf(T);
            T = DBUF[u * 128 + dd] * T + LBUF[(size_t)u * 32768 + idx]; }
    }
}

constexpr int GLC_TS = 0, GLC_OS = 67584, PO = 1056;
__device__ __forceinline__ void gla_phase_c(Frame& F) {
    unsigned char* ws = F.ws;
    const bf16* GQ = (const bf16*)(ws + WS_GQ); const bf16* GV = (const bf16*)(ws + WS_GV); bf16* GR = (bf16*)(ws + WS_GR); const bf16* TT = (const bf16*)(ws + WS_TT);
    LAS unsigned char* L = F.lds + RING_OFF;
    const int tid = F.tid, lane = F.lane, w = F.wave, hi = lane >> 5, l31 = lane & 31;
    const int g1 = (lane >> 4) & 1, q = (lane & 15) >> 2, p = lane & 3;
    for (int u2 = F.vcu; u2 < 256; u2 += F.G) {
        const int u = u2 >> 1, half = u2 & 1, b = u >> 6, h = (u >> 4) & 3, j = u & 15;
        __syncthreads();
        { const int tr = tid >> 2, seg = tid & 3;
#pragma unroll
          for (int q8 = 0; q8 < 8; ++q8) *(LAS v4u*)(L + GLC_TS + tr * PV + (64 * seg + 8 * q8) * 2) = *(const v4u*)(TT + (size_t)u * 32768 + tr * 256 + 64 * seg + 8 * q8); }
        __syncthreads();
        s16x8 tf[8];
#pragma unroll
        for (int ks = 0; ks < 8; ++ks) { const LAS unsigned char* tp = L + GLC_TS + (16 * ks + 8 * hi + q) * PV + (32 * w + 16 * g1 + 4 * p) * 2; tf[ks] = cat8(ldtr(tp), ldtr(tp + 4 * PV)); }
        for (int c = 0; c < 4; ++c) {
            const int row0 = b * TSEQ + 512 * j + 256 * half + 64 * c;
#pragma unroll 1
            for (int ti = 0; ti < 2; ++ti) {
                f32x16 o = (f32x16){};
                const bf16* qrow = GQ + (size_t)(row0 + 32 * ti + l31) * 512 + 128 * h + 8 * hi;
#pragma unroll
                for (int ks = 0; ks < 8; ++ks) { const s16x8 af = *(const s16x8*)(qrow + 16 * ks); o = __builtin_amdgcn_mfma_f32_32x32x16_bf16(af, tf[ks], o, 0, 0, 0); }
#pragma unroll
                for (int r = 0; r < 16; ++r) *(LAS float*)(L + GLC_OS + crow16(r, hi) * PO + (32 * w + l31) * 4) = o[r];
                __syncthreads();
#pragma unroll
                for (int rr = 0; rr < 4; ++rr) { const int lr = 4 * w + rr, row = row0 + 32 * ti + lr;
                    const f32x4 ov = *(const LAS f32x4*)(L + GLC_OS + lr * PO + lane * 16);
                    const u32x2 ol = *(const u32x2*)(GV + (size_t)row * 1024 + 256 * h + 4 * lane);
                    const u32x2 rv = *(const u32x2*)(GR + (size_t)row * 1024 + 256 * h + 4 * lane);
                    const f32x4 gn4 = *(const f32x4*)(F.gn + 4 * lane);
                    f32x4 t4; t4[0] = ov[0] + bf2f((unsigned short)(ol.x & 0xffff)); t4[1] = ov[1] + bf2f((unsigned short)(ol.x >> 16)); t4[2] = ov[2] + bf2f((unsigned short)(ol.y & 0xffff)); t4[3] = ov[3] + bf2f((unsigned short)(ol.y >> 16));
                    const float ss = wave_sum((t4[0] * t4[0] + t4[1] * t4[1]) + (t4[2] * t4[2] + t4[3] * t4[3]));
                    const float rs = 1.f / sqrtf(ss * (1.f / 256.f) + 1e-6f);
                    f32x4 y; y[0] = t4[0] * rs * gn4[0] * bf2f((unsigned short)(rv.x & 0xffff)); y[1] = t4[1] * rs * gn4[1] * bf2f((unsigned short)(rv.x >> 16));
                    y[2] = t4[2] * rs * gn4[2] * bf2f((unsigned short)(rv.y & 0xffff)); y[3] = t4[3] * rs * gn4[3] * bf2f((unsigned short)(rv.y >> 16));
                    *(u32x2*)(GR + (size_t)row * 1024 + 256 * h + 4 * lane) = (u32x2){pk2(y[0], y[1]), pk2(y[2], y[3])}; }
                __syncthreads();
            }
        }
    }
}


namespace ix {
constexpr int IQP = 1040;
constexpr int OFF_IQ = 0, OFF_H = 33280, HPW = 356  , OFF_M = OFF_H + 32 * HPW * 4, OFF_RI = OFF_M + 32 * MASKW * 4, OFF_CC = OFF_RI + 384;
constexpr int NB = 708, CAP = 128;
static_assert(32 * CAP * 8 <= 32 * HPW * 4 && OFF_CC + 128 <= RING_BYTES, "indexer LDS map");
__device__ __forceinline__ int score_bin(float s) {
    const unsigned b = __float_as_uint(s);
    int mag = (int)((b & 0x7fffffffu) >> 18) - (120 * 32 - 1);
    mag = mag < 0 ? 0 : (mag > 353 ? 353 : mag);
    return 354 + (mag ^ ((int)b >> 31));
}
__device__ __forceinline__ void tile_scores(f32x16& sc, const bf16* IKb, int kt, LAS unsigned char* L, int r32, int hi, const float (&iw)[8]) {
    s16x8 kf[4];
    const bf16* kp = IKb + (size_t)(32 * kt + r32) * 64 + 8 * hi;
#pragma unroll
    for (int d0 = 0; d0 < 4; ++d0) kf[d0] = *(const s16x8*)(kp + 16 * d0);
    sc = (f32x16){};
#pragma unroll
    for (int h = 0; h < 8; ++h) {
        f32x16 a = (f32x16){};
#pragma unroll
        for (int d0 = 0; d0 < 4; ++d0) { const s16x8 qf = *(const LAS s16x8*)(L + OFF_IQ + r32 * IQP + (h * 64 + 16 * d0 + 8 * hi) * 2);
            a = __builtin_amdgcn_mfma_f32_32x32x16_bf16(kf[d0], qf, a, 0, 0, 0); }
#pragma unroll
        for (int r = 0; r < 16; ++r) sc[r] += iw[h] * fmaxf(a[r], 0.f);
    }
#pragma unroll
    for (int r = 0; r < 16; ++r) sc[r] += 0.0f;
}
}

__device__ __forceinline__ void idx_phase(Frame& F) {
    using namespace ix;
    unsigned char* ws = F.ws;
    const bf16* IQ = (const bf16*)(ws + WS_IQ); const bf16* IKB = (const bf16*)(ws + WS_IKB); const float* IW = (const float*)(ws + WS_IW); unsigned* MASK = (unsigned*)(ws + WS_MASK);
    LAS unsigned char* L = F.lds + RING_OFF;
    const int tid = F.tid, lane = F.lane, w = F.wave, hi = lane >> 5, r32 = lane & 31;
    for (int v = F.vcu; v < 256; v += F.G) {
        const int b = v >> 7, m = v & 127;
#pragma unroll 1
        for (int ui = 0; ui < 2; ++ui) {
            const int qb = ui ? 255 - m : m;
            const int row0 = b * TSEQ + 32 * qb;
            const int qpos = NMETA + 32 * qb + r32;
            const int nkt = qb + 2;
            const bf16* IKb = IKB + (size_t)b * KVR * 64;
            __syncthreads();
            { const int rr = tid >> 4, seg = tid & 15;
#pragma unroll
              for (int q4 = 0; q4 < 4; ++q4) *(LAS v4u*)(L + OFF_IQ + rr * IQP + (32 * seg + 8 * q4) * 2) = *(const v4u*)(IQ + (size_t)(row0 + rr) * 512 + 32 * seg + 8 * q4); }
            for (int i = tid; i < 32 * HPW + 32 * MASKW + 128; i += 512) ((LAS unsigned*)(L + OFF_H))[i] = 0u;
            float iw[8];
            { const f32x4 a = *(const f32x4*)(IW + (size_t)(row0 + r32) * 8), c = *(const f32x4*)(IW + (size_t)(row0 + r32) * 8 + 4);
              iw[0] = a[0]; iw[1] = a[1]; iw[2] = a[2]; iw[3] = a[3]; iw[4] = c[0]; iw[5] = c[1]; iw[6] = c[2]; iw[7] = c[3]; }
            __syncthreads();
            for (int kt = w; kt < nkt; kt += 8) {
                f32x16 sc; tile_scores(sc, IKb, kt, L, r32, hi, iw);
                const bool edge = kt >= qb;
#pragma unroll
                for (int r = 0; r < 16; ++r) { const int key = 32 * kt + crow16(r, hi);
                    if (!edge || key <= qpos) { const int bin = score_bin(sc[r]);
                        __hip_atomic_fetch_add((LAS unsigned*)(L + OFF_H) + r32 * HPW + (bin >> 1), 1u << (16 * (bin & 1)), __ATOMIC_RELAXED, __HIP_MEMORY_SCOPE_WORKGROUP); } }
            }
            __syncthreads();
#pragma unroll 1
            for (int rr = 0; rr < 4; ++rr) {
                const int row = 4 * w + rr, n = NMETA + 32 * qb + row + 1;
                LAS int* ri = (LAS int*)(L + OFF_RI) + row * 3;
                if (n <= 256) { if (lane == 0) { ri[0] = -1; ri[1] = 0; ri[2] = 0; } continue; }
                const LAS unsigned short* hs = (const LAS unsigned short*)(L + OFF_H + row * HPW * 4);
                const int hib = NB - 1 - 12 * lane;
                int s = 0;
#pragma unroll
                for (int k = 0; k < 12; ++k) { const int bin = hib - k; if (bin >= 0) s += hs[bin]; }
                int P = s;
#pragma unroll
                for (int o = 1; o < 64; o <<= 1) { const int t = __shfl_up(P, o); if (lane >= o) P += t; }
                const unsigned long long bal = __ballot(P >= 256);
                const int first = bal ? __builtin_ctzll(bal) : 63;
                if (lane == first) { int chi = P - s; int bs = -1, need = 0, cb = 0;
                    for (int k = 0; k < 12; ++k) { const int bin = hib - k; if (bin < 0) break; const int c = hs[bin];
                        if (chi + c >= 256) { bs = bin; need = 256 - chi; cb = c; break; } chi += c; }
                    ri[0] = bs; ri[1] = need; ri[2] = cb; }
            }
            __syncthreads();
            const int bstar = ((const LAS int*)(L + OFF_RI))[r32 * 3];
            for (int kt = w; kt < nkt; kt += 8) {
                f32x16 sc; tile_scores(sc, IKb, kt, L, r32, hi, iw);
                const bool edge = kt >= qb; unsigned bits = 0u;
#pragma unroll
                for (int r = 0; r < 16; ++r) { const int key = 32 * kt + crow16(r, hi);
                    if (!edge || key <= qpos) { const int bin = score_bin(sc[r]);
                        if (bin > bstar) bits |= 1u << crow16(r, hi);
                        else if (bin == bstar) { const unsigned slot = __hip_atomic_fetch_add((LAS unsigned*)(L + OFF_CC) + r32, 1u, __ATOMIC_RELAXED, __HIP_MEMORY_SCOPE_WORKGROUP);
                            if (slot < (unsigned)CAP) { LAS unsigned* cd = (LAS unsigned*)(L + OFF_H) + (r32 * CAP + slot) * 2; cd[0] = __float_as_uint(sc[r]); cd[1] = (unsigned)key; } } } }
                if (bits) __hip_atomic_fetch_or((LAS unsigned*)(L + OFF_M) + r32 * MASKW + kt, bits, __ATOMIC_RELAXED, __HIP_MEMORY_SCOPE_WORKGROUP);
            }
            __syncthreads();
#pragma unroll 1
            for (int rr = 0; rr < 4; ++rr) {
                const int row = 4 * w + rr;
                const int need = ((const LAS int*)(L + OFF_RI))[row * 3 + 1];
                int cnt = (int)((const LAS unsigned*)(L + OFF_CC))[row]; cnt = cnt > CAP ? CAP : cnt;
                const LAS unsigned* cd = (const LAS unsigned*)(L + OFF_H) + row * CAP * 2;
                for (int c = lane; c < cnt; c += 64) {
                    const float sc_ = __uint_as_float(cd[2 * c]); const unsigned ic = cd[2 * c + 1];
                    int rank = 0;
                    for (int c2 = 0; c2 < cnt; ++c2) { const float s2 = __uint_as_float(cd[2 * c2]); const unsigned i2 = cd[2 * c2 + 1]; rank += (s2 > sc_ || (s2 == sc_ && i2 < ic)) ? 1 : 0; }
                    if (rank < need) __hip_atomic_fetch_or((LAS unsigned*)(L + OFF_M) + row * MASKW + (ic >> 5), 1u << (ic & 31), __ATOMIC_RELAXED, __HIP_MEMORY_SCOPE_WORKGROUP);
                }
            }
            __syncthreads();
            const int nw = 2 * (4 * (qb >> 3) + 6);
            for (int i = tid; i < 32 * MASKW; i += 512) { const int row = i / MASKW, wd = i - row * MASKW;
                if (wd < nw) MASK[(size_t)(row0 + row) * MASKW + wd] = ((const LAS unsigned*)(L + OFF_M))[i]; }
        }
    }
}


namespace at {
constexpr int D = 128, NW = 8, QBLK = 32, KVBLK = 64, LDX = 1024;
constexpr float THR = 8.f;
constexpr size_t SHM_V = KVBLK * D * 2, SHM_K = KVBLK * D * 2;
constexpr int OFF_WS = 2 * SHM_V + 2 * SHM_K, OFF_BT = OFF_WS + NW * 64 * 4;
#define KSWZ(row, colB) ((row) * 256 + ((colB) ^ (((row) & 7) << 4)))
#define SBAR() __builtin_amdgcn_sched_barrier(0)
__device__ __forceinline__ unsigned cvtpk(float lo, float hi) { unsigned r; asm volatile("v_cvt_pk_bf16_f32 %0, %1, %2" : "=v"(r) : "v"(lo), "v"(hi)); return r; }
__device__ __forceinline__ void partialSM(f32x16& p0, f32x16& p1, float& m_reg, float& mn, float& alpha) {
  float pmax = p0[0];
#pragma unroll
  for (int r = 1; r < 16; ++r) pmax = fmaxf(pmax, p0[r]);
#pragma unroll
  for (int r = 0; r < 16; ++r) pmax = fmaxf(pmax, p1[r]);
  { auto rr = __builtin_amdgcn_permlane32_swap(__float_as_uint(pmax), __float_as_uint(pmax), false, false);
    pmax = fmaxf(__uint_as_float(rr[0]), __uint_as_float(rr[1])); }
  if (__builtin_expect(__all(pmax - m_reg <= THR), 1)) { mn = m_reg; alpha = 1.f; }
  else { mn = fmaxf(m_reg, pmax); alpha = __builtin_amdgcn_exp2f(m_reg - mn); m_reg = mn; }
#pragma unroll
  for (int r = 0; r < 16; ++r) p0[r] = p0[r] - mn;
#pragma unroll
  for (int r = 0; r < 16; ++r) p1[r] = p1[r] - mn;
#pragma unroll
  for (int r = 0; r < 16; ++r) p0[r] = __builtin_amdgcn_exp2f(p0[r]);
}
__device__ __forceinline__ void finishSM(f32x16& p0, f32x16& p1, float alpha, float& l_reg, s16x8& pa0, s16x8& pa1, s16x8& pa2, s16x8& pa3) {
#pragma unroll
  for (int r = 0; r < 16; ++r) p1[r] = __builtin_amdgcn_exp2f(p1[r]);
  float ps = 0;
#pragma unroll
  for (int r = 0; r < 16; ++r) ps += p0[r];
#pragma unroll
  for (int r = 0; r < 16; ++r) ps += p1[r];
  { auto rr = __builtin_amdgcn_permlane32_swap(__float_as_uint(ps), __float_as_uint(ps), false, false);
    ps = __uint_as_float(rr[0]) + __uint_as_float(rr[1]); }
  l_reg = l_reg * alpha + ps;
#define PK4(P, BASE, OUT) do { unsigned a0 = cvtpk(P[BASE + 0], P[BASE + 1]), a1 = cvtpk(P[BASE + 2], P[BASE + 3]);   \
    unsigned b0 = cvtpk(P[BASE + 4], P[BASE + 5]), b1 = cvtpk(P[BASE + 6], P[BASE + 7]);                              \
    auto r0 = __builtin_amdgcn_permlane32_swap(a0, b0, false, false); auto r1 = __builtin_amdgcn_permlane32_swap(a1, b1, false, false); \
    v4u w_ = {r0[0], r1[0], r0[1], r1[1]}; OUT = __builtin_bit_cast(s16x8, w_); } while (0)
  PK4(p0, 0, pa0); PK4(p0, 8, pa1); PK4(p1, 0, pa2); PK4(p1, 8, pa3);
#undef PK4
}
__device__ __forceinline__ void qkt(f32x16& p0, f32x16& p1, const unsigned char* Ks, const s16x8* qr, int r32, int hi) {
#pragma unroll
  for (int d0 = 0; d0 < 8; ++d0) { const int cb = (d0 * 16 + hi * 8) * 2;
    const s16x8 b0 = *reinterpret_cast<const s16x8*>(Ks + KSWZ(r32, cb));
    const s16x8 b1 = *reinterpret_cast<const s16x8*>(Ks + KSWZ(32 + r32, cb));
    p0 = __builtin_amdgcn_mfma_f32_32x32x16_bf16(b0, qr[d0], p0, 0, 0, 0);
    p1 = __builtin_amdgcn_mfma_f32_32x32x16_bf16(b1, qr[d0], p1, 0, 0, 0); }
}
__device__ __forceinline__ int v_st(int k, int c) { const int kk = (k & ~0xC) | ((k & 4) << 1) | ((k & 8) >> 1); return ((kk >> 3) * 4 + (c >> 5)) * 512 + ((kk & 7) * 32 + (c & 31)) * 2; }
__device__ __forceinline__ int v_rd_base(int lane) { return ((lane & 3) << 3) | (((lane >> 2) & 3) << 6) | (((lane >> 4) & 1) << 5) | (((lane >> 5) & 1) << 8); }
constexpr int v_rd_off(int d0, int ks, int half) { return d0 * 512 + ks * 4096 + half * 2048; }
template <int OFF> __device__ __forceinline__ s16x4v tr_read(int vb) {
  s16x4v r; asm volatile("ds_read_b64_tr_b16 %0, %1 offset:%2" : "=&v"(r) : "v"(vb), "i"(OFF) : "memory"); return r;
}
template <int D0> __device__ __forceinline__ void pv_one(f32x16& od, int vb, s16x8 pa0, s16x8 pa1, s16x8 pa2, s16x8 pa3) {
  const s16x4v l0 = tr_read<v_rd_off(D0, 0, 0)>(vb), h0 = tr_read<v_rd_off(D0, 0, 1)>(vb), l1 = tr_read<v_rd_off(D0, 1, 0)>(vb), h1 = tr_read<v_rd_off(D0, 1, 1)>(vb);
  const s16x4v l2 = tr_read<v_rd_off(D0, 2, 0)>(vb), h2 = tr_read<v_rd_off(D0, 2, 1)>(vb), l3 = tr_read<v_rd_off(D0, 3, 0)>(vb), h3 = tr_read<v_rd_off(D0, 3, 1)>(vb);
  asm volatile("s_waitcnt lgkmcnt(0)" ::: "memory"); SBAR();
#define PK(L, H) (s16x8){L[0], L[1], L[2], L[3], H[0], H[1], H[2], H[3]}
  od = __builtin_amdgcn_mfma_f32_32x32x16_bf16(pa0, PK(l0, h0), od, 0, 0, 0);
  od = __builtin_amdgcn_mfma_f32_32x32x16_bf16(pa1, PK(l1, h1), od, 0, 0, 0);
  od = __builtin_amdgcn_mfma_f32_32x32x16_bf16(pa2, PK(l2, h2), od, 0, 0, 0);
  od = __builtin_amdgcn_mfma_f32_32x32x16_bf16(pa3, PK(l3, h3), od, 0, 0, 0);
#undef PK
}
__device__ __forceinline__ void pv_d0(f32x16* o, int vb, s16x8 pa0, s16x8 pa1, s16x8 pa2, s16x8 pa3) {
  pv_one<0>(o[0], vb, pa0, pa1, pa2, pa3); pv_one<1>(o[1], vb, pa0, pa1, pa2, pa3); pv_one<2>(o[2], vb, pa0, pa1, pa2, pa3); pv_one<3>(o[3], vb, pa0, pa1, pa2, pa3);
}
__device__ __forceinline__ void mk_init(f32x16& p0, f32x16& p1, u32x2 mw, int t, int qpos, int hi, bool near, const float* bt) {
  const unsigned w0 = mw.x >> (4 * hi), w1 = mw.y >> (4 * hi);
  const float NEG = -INFINITY;
  if (near) {
    const int db = qpos - (64 * t + 4 * hi);
#pragma unroll
    for (int r = 0; r < 16; ++r) { const int c = (r & 3) + 8 * (r >> 2);
      int d0 = db - c, d1 = db - 32 - c; d0 = d0 < 0 ? 0 : (d0 > 127 ? 127 : d0); d1 = d1 < 0 ? 0 : (d1 > 127 ? 127 : d1);
      p0[r] = ((w0 >> c) & 1u) ? bt[d0] : NEG; p1[r] = ((w1 >> c) & 1u) ? bt[d1] : NEG; }
  } else {
#pragma unroll
    for (int r = 0; r < 16; ++r) { const int c = (r & 3) + 8 * (r >> 2);
      p0[r] = ((w0 >> c) & 1u) ? 0.f : NEG; p1[r] = ((w1 >> c) & 1u) ? 0.f : NEG; }
  }
}

__device__ __forceinline__ void attn_unit(const bf16* __restrict__ Qb, const bf16* __restrict__ Kh, const bf16* __restrict__ Vh, bf16* Ob, const unsigned* __restrict__ Mb, int qpos0, int NT, const float* btg, unsigned char* lds) {
  int tid_ = threadIdx.x; asm volatile("" : "+v"(tid_));
  const int tid = tid_, wid = __builtin_amdgcn_readfirstlane(tid >> 6), lane = tid & 63, r32 = lane & 31, hi = lane >> 5;
  unsigned char* V_lds = lds; unsigned char* K_lds = lds + 2 * SHM_V;
  float* ws = (float*)(lds + OFF_WS) + wid * 64; float* li_l = ws; float* al_l = ws + 32;
  float* bt = (float*)(lds + OFF_BT);
  if (tid < 128) bt[tid] = btg[tid];
  float m_reg = -1e30f, l_reg = 0; f32x16 o[4] = {}; s16x8 qr[8];
  const bf16* Qw = Qb + (long)(wid * QBLK + r32) * LDX + hi * 8;
#pragma unroll
  for (int d0 = 0; d0 < 8; ++d0) qr[d0] = *reinterpret_cast<const s16x8*>(Qw + d0 * 16);
  const int sr = tid >> 4, sc = (tid & 15) * 8, vst0 = v_st(sr, sc), kst0 = KSWZ(sr, sc * 2);
  const int vb0 = (int)(uintptr_t)V_lds + v_rd_base(lane);
  struct { s16x8 vs0, vs1, ks0, ks1; } sr_[1];
  const int qpos = qpos0 + wid * QBLK + r32, qmin = qpos0 + wid * QBLK;
  const unsigned moff = (unsigned)((wid * QBLK + r32) * MASKW * 4);
  const unsigned voff0 = (unsigned)((sr * LDX + sc) * 2);
#define SLOAD(i, k0) do { const char* vt_ = (const char*)Vh + (size_t)(k0) * (LDX * 2); const char* kt_ = (const char*)Kh + (size_t)(k0) * (LDX * 2); \
    sr_[i].vs0 = *(const s16x8*)(vt_ + voff0); sr_[i].vs1 = *(const s16x8*)((vt_ + 32 * LDX * 2) + voff0); \
    sr_[i].ks0 = *(const s16x8*)(kt_ + voff0); sr_[i].ks1 = *(const s16x8*)((kt_ + 32 * LDX * 2) + voff0); } while (0)
#define SWRITE(b, i) do { *(s16x8*)(V_lds + (b) * SHM_V + vst0) = sr_[i].vs0;          \
    *(s16x8*)(V_lds + (b) * SHM_V + 8192 + vst0) = sr_[i].vs1;               \
    *(s16x8*)(K_lds + (b) * SHM_K + kst0) = sr_[i].ks0;                       \
    *(s16x8*)(K_lds + (b) * SHM_K + 8192 + kst0) = sr_[i].ks1; } while (0)
#define SWAIT() asm volatile("s_waitcnt vmcnt(0)" ::: "memory")
#define RESC(a) do { if (__any((a) < 1.f)) { if (hi == 0) al_l[r32] = (a); asm volatile("s_waitcnt lgkmcnt(0)" ::: "memory"); \
    _Pragma("unroll") for (int d = 0; d < 4; ++d) _Pragma("unroll") for (int r = 0; r < 16; ++r) o[d][r] *= al_l[crow16(r, hi)]; } } while (0)
#define MLOAD(t) (*(const u32x2*)((const char*)Mb + (size_t)(8 * (t)) + moff))
#define NEAR(t) (64 * (t) + 63 + 113 > qmin)
  f32x16 pA0, pA1, pB0, pB1; float mnA, mnB, alA, alB; s16x8 pa0, pa1, pa2, pa3;
  constexpr int SE = 0, SO = 0;
  SLOAD(SE, 0); asm volatile("s_waitcnt vmcnt(0)" ::: "memory"); SWRITE(0, SE); __syncthreads();
  mk_init(pA0, pA1, MLOAD(0), 0, qpos, hi, NEAR(0), bt);
  qkt(pA0, pA1, K_lds, qr, r32, hi); partialSM(pA0, pA1, m_reg, mnA, alA);
  SLOAD(SO, KVBLK);
  SWAIT(); SWRITE(1, SO); __syncthreads();
  for (int j = 1; j + 1 < NT; j += 2) {
    mk_init(pB0, pB1, MLOAD(j), j, qpos, hi, NEAR(j), bt);
    SBAR(); qkt(pB0, pB1, K_lds + SHM_K, qr, r32, hi);
    finishSM(pA0, pA1, alA, l_reg, pa0, pa1, pa2, pa3); SBAR();
    SLOAD(SO, (j + 1) * KVBLK); SBAR();
    pv_d0(o, vb0, pa0, pa1, pa2, pa3); partialSM(pB0, pB1, m_reg, mnB, alB);
    __syncthreads(); SWAIT(); SWRITE(0, SE);
    RESC(alB); __syncthreads();
    mk_init(pA0, pA1, MLOAD(j + 1), j + 1, qpos, hi, NEAR(j + 1), bt);
    SBAR(); qkt(pA0, pA1, K_lds, qr, r32, hi);
    finishSM(pB0, pB1, alB, l_reg, pa0, pa1, pa2, pa3); SBAR();
    SLOAD(SE, (j + 2) * KVBLK); SBAR();
    pv_d0(o, vb0 + (int)SHM_V, pa0, pa1, pa2, pa3); partialSM(pA0, pA1, m_reg, mnA, alA);
    __syncthreads(); SWAIT(); SWRITE(1, SO);
    RESC(alA); __syncthreads();
  }
  mk_init(pB0, pB1, MLOAD(NT - 1), NT - 1, qpos, hi, NEAR(NT - 1), bt);
  SBAR(); qkt(pB0, pB1, K_lds + SHM_K, qr, r32, hi);
  finishSM(pA0, pA1, alA, l_reg, pa0, pa1, pa2, pa3); SBAR();
  pv_d0(o, vb0, pa0, pa1, pa2, pa3); partialSM(pB0, pB1, m_reg, mnB, alB);
  __syncthreads(); RESC(alB);
  finishSM(pB0, pB1, alB, l_reg, pa0, pa1, pa2, pa3); SBAR();
  pv_d0(o, vb0 + (int)SHM_V, pa0, pa1, pa2, pa3);
  if (hi == 0) li_l[r32] = l_reg; asm volatile("s_waitcnt lgkmcnt(0)" ::: "memory");
  float rli[16];
#pragma unroll
  for (int r = 0; r < 16; ++r) rli[r] = __builtin_amdgcn_rcpf(li_l[crow16(r, hi)]);
  bf16* Ow = Ob + (long)(wid * QBLK + 4 * hi) * LDX + r32; asm volatile("" : "+v"(Ow));
#pragma unroll
  for (int r = 0; r < 16; ++r) {
#pragma unroll
    for (int d0 = 0; d0 < 4; ++d0) Ow[(long)((r & 3) + 8 * (r >> 2)) * LDX + d0 * 32] = (bf16)f2bf(o[d0][r] * rli[r]); }
  __syncthreads();
#undef SLOAD
#undef SWRITE
#undef SWAIT
#undef RESC
#undef MLOAD
#undef NEAR
}
#undef KSWZ
#undef SBAR
}

__device__ __forceinline__ void attn_phase(Frame& F) {
    unsigned char* ws = F.ws;
    bf16* DQ = (bf16*)(ws + WS_DQ); const bf16* DK = (const bf16*)(ws + WS_DKB); const bf16* DV = (const bf16*)(ws + WS_DVB);
    const unsigned* MASK = (const unsigned*)(ws + WS_MASK); const float* BT = (const float*)(ws + WS_BIAST);
    { const int v = F.vcu & 255;
        const int bh = v >> 4, s = v & 15, b = bh >> 3, h = bh & 7;
#pragma unroll 1
        for (int i = 0; i < 2; ++i) {
            const int jq = i ? 31 - s : s;
            const size_t qrow = (size_t)b * TSEQ + 256 * jq;
            at::attn_unit(DQ + qrow * 1024 + 128 * h, DK + (size_t)b * KVR * 1024 + 128 * h, DV + (size_t)b * KVR * 1024 + 128 * h, DQ + qrow * 1024 + 128 * h,
                          MASK + qrow * MASKW, NMETA + 256 * jq, 4 * jq + 6, BT + 128 * h, (unsigned char*)(F.lds + RING_OFF));
        }
    }
}


#ifndef MK_N_LAUNCHES
#define MK_N_LAUNCHES 1
#endif
#ifndef DBG_STOP
#define DBG_STOP 99
#endif
constexpr int NPH = 16;
constexpr int N_LAUNCHES = MK_N_LAUNCHES;
static_assert(N_LAUNCHES == 1 || N_LAUNCHES == NPH, "MK_N_LAUNCHES is 1 or NPH");
struct Args { const float* in[20]; float* out; unsigned char* ws; int ph_lo, ph_hi; };
__global__ void __launch_bounds__(NWAVES * 64, 2) fwd_kernel(Args args) {
    extern __shared__ __attribute__((aligned(16))) unsigned char lds[];
    Frame F;
    F.lds = (LAS unsigned char*)lds;
    F.MISC = (volatile LAS unsigned*)(F.lds + MISC_OFF);
    F.tid = threadIdx.x; F.lane = F.tid & 63; F.wave = __builtin_amdgcn_readfirstlane(F.tid >> 6);
    F.G = gridDim.x; { const int bx = blockIdx.x; F.vcu = (F.G % 8 == 0) ? (bx % 8) * (F.G / 8) + bx / 8 : bx; }
    unsigned char* ws = args.ws; F.ws = ws;
    F.ctl = (gu32*)(ws + WS_CTL);
    F.x = args.in[0]; F.meta = args.in[1]; F.n1 = args.in[2]; F.w1g = args.in[3]; F.w1u = args.in[4]; F.w1d = args.in[5]; F.nm = args.in[6]; F.win = args.in[7];
    F.wlr = args.in[8]; F.blr = args.in[9]; F.gn = args.in[10]; F.wa = args.in[11]; F.wb = args.in[12]; F.wo = args.in[13]; F.rb = args.in[14]; F.n2 = args.in[15];
    F.w2g = args.in[16]; F.w2u = args.in[17]; F.w2d = args.in[18]; F.nf = args.in[19]; F.out = args.out;
    for (int u = F.tid; u < (LDS_BYTES - LDSCTL_OFF) / 4; u += NWAVES * 64) ((LAS unsigned*)(F.lds + LDSCTL_OFF))[u] = 0u;
    __syncthreads();
    XcdBarrier bar; bar.bar = (unsigned*)(F.ctl + CW_BAR); bar.x = 0; bar.st = nullptr;
    if (N_LAUNCHES == 1) bar = xcd_barrier_post((unsigned*)(F.ctl + CW_BAR), F.MISC + 8);
    const int lo = args.ph_lo, hi = args.ph_hi;
#define IN(k) (lo <= (k) && (k) < hi && (k) < DBG_STOP)
#define SEAM() do { if (N_LAUNCHES == 1) xcd_barrier(bar); } while (0)
    typedef pg8::bf16_t b16;
    b16* XN = (b16*)(ws + WS_XN);
    float* SSQA = (float*)(ws + WS_SSQA); float* SSQB = (float*)(ws + WS_SSQB); float* SSQC = (float*)(ws + WS_SSQC);

    if (IN(0)) { p0_prologue(F); SEAM(); }
    if (IN(1)) {
        pg8::Gemm g{XN, (const b16*)(ws + WS_W1GU), NROWS, 5632, 1024, nullptr, nullptr}; pg8::StaticOrder S; S.init(NROWS, 5632, F.G, (int)blockIdx.x);
        pg8::EpiSwiglu E{(b16*)(ws + WS_HB), DFF, nullptr};
        pg8::gemm_phase<pg8::EpiSwiglu, pg8::StaticOrder, true, true>(F.lds + RING_OFF, g, S, E);
        SEAM();
    }
    if (IN(2)) {
        pg8::Gemm g{(const b16*)(ws + WS_HB), (const b16*)(ws + WS_W1D), NROWS, 1024, DFF, nullptr, nullptr}; pg8::StaticOrder S; S.init(NROWS, 1024, F.G, (int)blockIdx.x);
        pg8::EpiResid E{F.x, F.out, F.meta, (float*)(ws + WS_METAH), 0.5f, XN, F.nm, SSQA, NREAL};
        pg8::gemm_phase<pg8::EpiResid, pg8::StaticOrder, true, true>(F.lds + RING_OFF, g, S, E);
        SEAM();
    }
    pg8::EpiWin EW{SSQA, 0, (b16*)(ws + WS_GQ), (b16*)(ws + WS_GK), (b16*)(ws + WS_GV), (b16*)(ws + WS_GR), (b16*)(ws + WS_IQ), (b16*)(ws + WS_DQ), (b16*)(ws + WS_DKB), (b16*)(ws + WS_DVB),
                   (b16*)(ws + WS_GA), (b16*)(ws + WS_GB), (b16*)(ws + WS_IKB), (float*)(ws + WS_GLR), (float*)(ws + WS_IW)};
    if (IN(3)) {
        pg8::Gemm g{XN, (const b16*)(ws + WS_WIN), NROWS, 15 * 256, 1024, nullptr, nullptr}; pg8::StaticOrder S; S.init(NROWS, 15 * 256, F.G, (int)blockIdx.x);
        EW.ct0 = 0;
        pg8::gemm_phase<pg8::EpiWin, pg8::StaticOrder, true, true>(F.lds + RING_OFF, g, S, EW);
        SEAM();
    }
    if (IN(4)) { gla_phase_a(F); SEAM(); }
    if (IN(5)) { gla_phase_b(F); SEAM(); }
    if (IN(6)) { gla_phase_c(F); SEAM(); }
    if (IN(7)) { idx_phase(F); SEAM(); }
    if (IN(8)) {
        pg8::Gemm g{XN, (const b16*)(ws + WS_WIN) + (size_t)15 * 256 * 1024, NROWS, 12 * 256, 1024, nullptr, nullptr}; pg8::StaticOrder S; S.init(NROWS, 12 * 256, F.G, (int)blockIdx.x);
        EW.ct0 = 15;
        pg8::gemm_phase<pg8::EpiWin, pg8::StaticOrder, true, true>(F.lds + RING_OFF, g, S, EW);
        SEAM();
    }
    if (IN(9)) { attn_phase(F); SEAM(); }
    if (IN(10)) {
        pg8::Gemm g{XN, (const b16*)(ws + WS_WIN) + (size_t)27 * 256 * 1024, NREAL, 8 * 256, 1024, nullptr, nullptr}; pg8::StaticOrder S; S.init(NREAL, 8 * 256, F.G, (int)blockIdx.x);
        EW.ct0 = 27;
        pg8::gemm_phase<pg8::EpiWin, pg8::StaticOrder, true, true>(F.lds + RING_OFF, g, S, EW);
        SEAM();
    }
    if (IN(11)) {
        pg8::Gemm g{(const b16*)(ws + WS_GR), (const b16*)(ws + WS_WA), NREAL, 1024, 1024, (const b16*)(ws + WS_DQ), (const b16*)(ws + WS_WB)}; pg8::PairOrder S; S.init(NREAL, 1024, F.G, (int)blockIdx.x);
        pg8::EpiMerge E{(const b16*)(ws + WS_GA), (const b16*)(ws + WS_GB), XN};
        pg8::gemm_phase<pg8::EpiMerge, pg8::PairOrder, false, true>(F.lds + RING_OFF, g, S, E);
        SEAM();
    }
    if (IN(12)) {
        pg8::Gemm g{XN, (const b16*)(ws + WS_WO), NREAL, 1024, 1024, nullptr, nullptr}; pg8::StaticOrder S; S.init(NREAL, 1024, F.G, (int)blockIdx.x);
        pg8::EpiResid E{F.out, F.out, nullptr, nullptr, 1.0f, (b16*)(ws + WS_A3), F.n2, SSQB, NREAL};
        pg8::gemm_phase<pg8::EpiResid, pg8::StaticOrder, true, true>(F.lds + RING_OFF, g, S, E);
        SEAM();
    }
    if (IN(13)) {
        pg8::Gemm g{(const b16*)(ws + WS_A3), (const b16*)(ws + WS_W2GU), NREAL, 5632, 1024, nullptr, nullptr}; pg8::StaticOrder S; S.init(NREAL, 5632, F.G, (int)blockIdx.x);
        pg8::EpiSwiglu E{(b16*)(ws + WS_HB2), DFF, SSQB};
        pg8::gemm_phase<pg8::EpiSwiglu, pg8::StaticOrder, true, true>(F.lds + RING_OFF, g, S, E);
        SEAM();
    }
    if (IN(14)) {
        pg8::Gemm g{(const b16*)(ws + WS_HB2), (const b16*)(ws + WS_W2D), NREAL, 1024, DFF, nullptr, nullptr}; pg8::StaticOrder S; S.init(NREAL, 1024, F.G, (int)blockIdx.x);
        pg8::EpiResid E{F.out, F.out, nullptr, nullptr, 0.5f, nullptr, nullptr, SSQC, NREAL};
        pg8::gemm_phase<pg8::EpiResid, pg8::StaticOrder, true, true>(F.lds + RING_OFF, g, S, E);
        SEAM();
    }

    if (lo <= 15 && 15 < hi) { p_final(F, DBG_STOP <= 12 ? SSQA : (DBG_STOP <= 14 ? SSQB : SSQC)); }
#undef IN
#undef SEAM
}

extern "C" void kernel_launch(void* const* d_in, const int* in_sizes, int n_in, void* d_out, int out_size, void* d_ws, size_t ws_size, hipStream_t stream) {
    static int grid = 0;
    if (grid == 0) {
        if (n_in != 20 || out_size != NREAL * DM || ws_size < WS_END) { fprintf(stderr, "kernel_launch: unexpected shapes: n_in %d out %d ws %zu\n", n_in, out_size, ws_size); grid = -1; return; }
        int dev = 0, cus = 0, per_cu = 0;
        if (hipGetDevice(&dev) != hipSuccess || hipDeviceGetAttribute(&cus, hipDeviceAttributeMultiprocessorCount, dev) != hipSuccess) { grid = -1; return; }
        if (hipFuncSetAttribute((const void*)fwd_kernel, hipFuncAttributeMaxDynamicSharedMemorySize, LDS_BYTES) != hipSuccess) { fprintf(stderr, "kernel_launch: hipFuncSetAttribute failed\n"); grid = -1; return; }
        if (hipOccupancyMaxActiveBlocksPerMultiprocessor(&per_cu, (const void*)fwd_kernel, NWAVES * 64, LDS_BYTES) != hipSuccess || per_cu < 1)
            fprintf(stderr, "kernel_launch: note: occupancy query reports %d workgroups per CU\n", per_cu);
        (void)hipGetLastError();
        grid = cus;
        if (grid > 256) grid = 256;
    }
    if (grid < 0) return;
    if (hipMemsetAsync((char*)d_ws + WS_CTL, 0, CTL_ZERO_BYTES, stream) != hipSuccess) { fprintf(stderr, "kernel_launch: memset failed\n"); return; }
    Args a{};
    for (int i = 0; i < 20; ++i) a.in[i] = (const float*)d_in[i];
    a.out = (float*)d_out; a.ws = (unsigned char*)d_ws;
    for (int li = 0; li < N_LAUNCHES; ++li) {
        a.ph_lo = (N_LAUNCHES == 1) ? 0 : li; a.ph_hi = (N_LAUNCHES == 1) ? NPH : li + 1;
        hipLaunchKernelGGL(fwd_kernel, dim3(grid), dim3(NWAVES * 64), LDS_BYTES, stream, a);
        const hipError_t le = hipPeekAtLastError();
        if (le != hipSuccess) { fprintf(stderr, "kernel_launch: launch %d failed: %s\n", li, hipGetErrorName(le)); break; }
    }
}
```

```cpp
#include <hip/hip_runtime.h>
#include <cstdio>
#include <cstdint>
#include <cmath>

namespace pg8 {
#define PG8_LAS __attribute__((address_space(3)))
typedef unsigned short bf16_t;
typedef short bf16x8 __attribute__((ext_vector_type(8)));
typedef float f32x4 __attribute__((ext_vector_type(4)));
typedef unsigned u32x4 __attribute__((ext_vector_type(4)));
constexpr int BM = 256, BK = 64, HALF = 128, HTB = HALF * BK * 2  , STAGE_BYTES = 8 * HTB, NXCD = 8, WGM = 8;

__host__ __device__ __forceinline__ int lds_byte(int r, int c) { const int st = (r >> 4) * 2 + (c >> 5), rr = r & 15, cc = c & 31, ob = rr * 64 + cc * 2; return st * 1024 + (ob ^ (((ob >> 9) & 1) << 5)); }
__host__ __device__ __forceinline__ void stage_rc(int b, int& R, int& C) { const int st = b / 1024, sb = b % 1024, swz = sb ^ (((sb >> 9) & 1) << 5); R = (st >> 1) * 16 + swz / 64; C = (st & 1) * 32 + (swz % 64) / 2; }
__host__ __device__ __forceinline__ int perm32(int rho) { const int n = rho >> 4, i = rho & 15; return 8 * (i >> 2) + 4 * n + (i & 3); }

struct Unit { int pm, pn, z; };
struct Gemm { const bf16_t* A; const bf16_t* Bt; int M, N, K; const bf16_t* A2; const bf16_t* Bt2; };

struct StaticOrder {
    int nM, nN, nwg, G, c;
    __host__ __device__ void init(int M, int N, int G_, int c_) { nM = M / BM; nN = N / BM; nwg = nM * nN; G = G_; c = c_; }
    __host__ __device__ bool next(int i, Unit& u) const {
        const long L = (long)i * G + c; if (L >= nwg) return false;
        int wgid = (int)L; { const int q = nwg / NXCD, r = nwg % NXCD, xcd = wgid % NXCD, off = wgid / NXCD; wgid = (xcd < r ? xcd * (q + 1) : r * (q + 1) + (xcd - r) * q) + off; }
        const int nig = WGM * nN, gid = wgid / nig, fm = gid * WGM, gsz = (nM - fm) < WGM ? (nM - fm) : WGM;
        u.pm = fm + ((wgid % nig) % gsz); u.pn = (wgid % nig) / gsz; u.z = 0; return true;
    }
    __device__ __forceinline__ void a_ready(const Unit&) const {}
    __device__ __forceinline__ void done(const Unit&) const {}
};


struct PairOrder {
    StaticOrder so;
    __host__ __device__ void init(int M, int N, int G_, int c_) { so.init(M, N, G_, c_); }
    __host__ __device__ bool next(int i, Unit& u) const { if (!so.next(i >> 1, u)) return false; u.z = i & 1; return true; }
    __device__ __forceinline__ void a_ready(const Unit&) const {}
    __device__ __forceinline__ void done(const Unit&) const {}
};

__device__ __forceinline__ unsigned f2bf_(float f) { unsigned u = __builtin_bit_cast(unsigned, f); return (u + 0x7fffu + ((u >> 16) & 1u)) >> 16; }
typedef float f32x2_pk_ __attribute__((ext_vector_type(2))); typedef __bf16 bf16x2_pk_ __attribute__((ext_vector_type(2)));
__device__ __forceinline__ unsigned pk2_(float lo, float hi) { f32x2_pk_ v = {lo, hi}; bf16x2_pk_ b = __builtin_convertvector(v, bf16x2_pk_); return __builtin_bit_cast(unsigned, b); }
__device__ __forceinline__ u32x4 pack8(const f32x4 a, const f32x4 b) { u32x4 w; w.x = pk2_(a[0], a[1]); w.y = pk2_(a[2], a[3]); w.z = pk2_(b[0], b[1]); w.w = pk2_(b[2], b[3]); return w; }
__device__ __forceinline__ float silu_f(float x) { return x * __builtin_amdgcn_rcpf(1.f + __builtin_amdgcn_exp2f(-1.4426950408889634f * x)); }
__device__ __forceinline__ float sigm_f(float x) { return __builtin_amdgcn_rcpf(1.f + __builtin_amdgcn_exp2f(-1.4426950408889634f * x)); }
__device__ __forceinline__ f32x4 silu4(f32x4 v) { return (f32x4){silu_f(v[0]), silu_f(v[1]), silu_f(v[2]), silu_f(v[3])}; }
__device__ __forceinline__ f32x4 sigm4(f32x4 v) { return (f32x4){sigm_f(v[0]), sigm_f(v[1]), sigm_f(v[2]), sigm_f(v[3])}; }
constexpr float RMS_EPS = 1e-6f;
__device__ __forceinline__ float rstd_row(const float* ssq, int row) {
    const f32x4* p = (const f32x4*)(ssq + (size_t)row * 16); const f32x4 a = p[0], b = p[1], c = p[2], d = p[3];
    const float s = ((a[0] + a[1]) + (a[2] + a[3])) + ((b[0] + b[1]) + (b[2] + b[3])) + ((c[0] + c[1]) + (c[2] + c[3])) + ((d[0] + d[1]) + (d[2] + d[3]));
    return __builtin_amdgcn_rsqf(s * (1.0f / 1024.0f) + RMS_EPS);
}

struct EpiSwiglu {
    static constexpr bool PERM = true, AFTER_DRAIN = false;
    bf16_t* H; int ldh; const float* ssq;
    __device__ __forceinline__ bool keep(const Unit&) const { return false; }
    __device__ __forceinline__ void operator()(f32x4 (&acc)[2][2][4][2], const Unit& u, int wr, int wc, int fr, int fq) const {
        const int row0 = u.pm * BM + wr * 64 + fr, col0 = u.pn * HALF + wc * 32 + 8 * fq;
#pragma unroll
        for (int ai = 0; ai < 2; ++ai)
#pragma unroll
            for (int m = 0; m < 4; ++m) {
                const int row = row0 + ai * HALF + m * 16;
                const float rs = ssq ? rstd_row(ssq, row) : 1.f;
                const f32x4 g0 = acc[ai][0][m][0] * rs, g1 = acc[ai][0][m][1] * rs, u0 = acc[ai][1][m][0] * rs, u1 = acc[ai][1][m][1] * rs;
                *(u32x4*)(H + (size_t)row * ldh + col0) = pack8(silu4(g0) * u0, silu4(g1) * u1);
            }
    }
};

struct EpiResid {
    static constexpr bool PERM = true, AFTER_DRAIN = false;
    const float* base; float* out; const float* mbase; float* mout; float alpha; bf16_t* xn; const float* gain; float* ssq; int nreal;
    __device__ __forceinline__ bool keep(const Unit&) const { return false; }
    __device__ __forceinline__ void operator()(f32x4 (&acc)[2][2][4][2], const Unit& u, int wr, int wc, int fr, int fq) const {
        const int row0 = u.pm * BM + wr * 64 + fr, colb = u.pn * BM + wc * 32 + 8 * fq;
#pragma unroll
        for (int ai = 0; ai < 2; ++ai)
#pragma unroll
            for (int m = 0; m < 4; ++m) {
                const int row = row0 + ai * HALF + m * 16;
                const float* bp; float* op;
                if (row < nreal) { bp = base + (size_t)row * 1024; op = out + (size_t)row * 1024; }
                else if (mbase && row < nreal + 16) { bp = mbase + (size_t)(row - nreal) * 1024; op = mout + (size_t)(row - nreal) * 1024; }
                else continue;
                float ss = 0.f;
#pragma unroll
                for (int bj = 0; bj < 2; ++bj) {
                    const int col = colb + bj * HALF;
                    const f32x4 b0 = *(const f32x4*)(bp + col), b1 = *(const f32x4*)(bp + col + 4);
                    const f32x4 h0 = b0 + acc[ai][bj][m][0] * alpha, h1 = b1 + acc[ai][bj][m][1] * alpha;
                    *(f32x4*)(op + col) = h0; *(f32x4*)(op + col + 4) = h1;
                    ss += (h0[0] * h0[0] + h0[1] * h0[1]) + (h0[2] * h0[2] + h0[3] * h0[3]) + (h1[0] * h1[0] + h1[1] * h1[1]) + (h1[2] * h1[2] + h1[3] * h1[3]);
                    if (xn) { const f32x4 g0 = *(const f32x4*)(gain + col), g1 = *(const f32x4*)(gain + col + 4);
                        *(u32x4*)(xn + (size_t)row * 1024 + col) = pack8(h0 * g0, h1 * g1); }
                }
                ss += __shfl_xor(ss, 16); ss += __shfl_xor(ss, 32);
                if (fq == 0 && ssq) ssq[(size_t)row * 16 + u.pn * 4 + wc] = ss;
            }
    }
};

struct EpiWin {
    static constexpr bool PERM = true, AFTER_DRAIN = false;
    const float* ssq; int ct0;
    bf16_t *GQ, *GK, *GV, *GR, *IQ, *DQ, *DK, *DV, *GA, *GB, *IK; float* GLR; float* IW;
    __device__ __forceinline__ bool keep(const Unit&) const { return false; }
    __device__ __forceinline__ static size_t kvrow(int row) { return (size_t)(row >> 13) * 8320 + 16 + (row & 8191); }
    __device__ __forceinline__ void operator()(f32x4 (&acc)[2][2][4][2], const Unit& u, int wr, int wc, int fr, int fq) const {
        const int ct = ct0 + u.pn;
        bf16_t* P; int ld, cb, mode; float sc = 1.f;
        if (ct < 2)       { P = GQ; ld = 512;  cb = ct * 256;        mode = 0; sc = 0.08838834764831845f; }
        else if (ct < 4)  { P = GK; ld = 512;  cb = (ct - 2) * 256;  mode = 1; }
        else if (ct < 8)  { P = GV; ld = 1024; cb = (ct - 4) * 256;  mode = 1; }
        else if (ct < 12) { P = GR; ld = 1024; cb = (ct - 8) * 256;  mode = 2; }
        else if (ct < 14) { P = IQ; ld = 512;  cb = (ct - 12) * 256; mode = 0; }
        else if (ct == 14){ P = IK; ld = 64;   cb = 0;               mode = 5; }
        else if (ct < 19) { P = DQ; ld = 1024; cb = (ct - 15) * 256; mode = 0; sc = 0.08838834764831845f * 1.4426950408889634f; }
        else if (ct < 23) { P = DK; ld = 1024; cb = (ct - 19) * 256; mode = 4; }
        else if (ct < 27) { P = DV; ld = 1024; cb = (ct - 23) * 256; mode = 4; }
        else if (ct < 31) { P = GA; ld = 1024; cb = (ct - 27) * 256; mode = 3; }
        else              { P = GB; ld = 1024; cb = (ct - 31) * 256; mode = 3; }
        const int row0 = u.pm * BM + wr * 64 + fr, cl = wc * 32 + 8 * fq;
#pragma unroll
        for (int ai = 0; ai < 2; ++ai)
#pragma unroll
            for (int m = 0; m < 4; ++m) {
                const int row = row0 + ai * HALF + m * 16;
                if (row >= 16400) continue;
                const bool meta = row >= 16384;
                if (meta && (mode == 0 || mode == 2 || mode == 3)) continue;
                const float rs = rstd_row(ssq, row) * sc;
#pragma unroll
                for (int bj = 0; bj < 2; ++bj) {
                    f32x4 v0 = acc[ai][bj][m][0] * rs, v1 = acc[ai][bj][m][1] * rs;
                    const int c = bj * HALF + cl;
                    if (mode == 5) {
                        if (bj == 1 || c >= 88) continue;
                        if (c < 16) { float* g = GLR + (size_t)row * 16 + c; *(f32x4*)g = v0; *(f32x4*)(g + 4) = v1; }
                        else if (c < 80) { const u32x4 w = pack8(v0, v1);
                            if (!meta) *(u32x4*)(IK + kvrow(row) * 64 + (c - 16)) = w;
                            else { *(u32x4*)(IK + (size_t)(row - 16384) * 64 + (c - 16)) = w; *(u32x4*)(IK + (size_t)(8320 + row - 16384) * 64 + (c - 16)) = w; } }
                        else if (!meta) { const float s = 0.04419417382415922f; float* g = IW + (size_t)row * 8; *(f32x4*)g = v0 * s; *(f32x4*)(g + 4) = v1 * s; }
                        continue;
                    }
                    if (mode == 2) { v0 = silu4(v0); v1 = silu4(v1); }
                    if (mode == 3) { v0 = sigm4(v0); v1 = sigm4(v1); }
                    const u32x4 w = pack8(v0, v1);
                    if (mode == 4) {
                        if (!meta) *(u32x4*)(P + kvrow(row) * ld + cb + c) = w;
                        else { *(u32x4*)(P + (size_t)(row - 16384) * ld + cb + c) = w; *(u32x4*)(P + (size_t)(8320 + row - 16384) * ld + cb + c) = w; }
                    } else *(u32x4*)(P + (size_t)row * ld + cb + c) = w;
                }
            }
    }
};

struct EpiMerge {
    static constexpr bool PERM = true, AFTER_DRAIN = false;
    const bf16_t* GA; const bf16_t* GB; bf16_t* O;
    __device__ __forceinline__ bool keep(const Unit& u) const { return u.z == 0; }
    __device__ __forceinline__ static float bf(unsigned short x) { return __builtin_bit_cast(float, (unsigned)x << 16); }
    __device__ __forceinline__ void operator()(f32x4 (&acc)[2][2][4][2], const Unit& u, int wr, int wc, int fr, int fq) const {
        const int row0 = u.pm * BM + wr * 64 + fr, colb = u.pn * BM + wc * 32 + 8 * fq;
#pragma unroll
        for (int ai = 0; ai < 2; ++ai)
#pragma unroll
            for (int m = 0; m < 4; ++m) {
                const int row = row0 + ai * HALF + m * 16;
#pragma unroll
                for (int bj = 0; bj < 2; ++bj) {
                    const size_t off = (size_t)row * 1024 + colb + bj * HALF;
                    const bf16x8 sb = *(const bf16x8*)(GB + off);
                    if (u.z == 0) {
                        const bf16x8 sa = *(const bf16x8*)(GA + off);
#pragma unroll
                        for (int e = 0; e < 4; ++e) {
                            acc[ai][bj][m][0][e] *= bf((unsigned short)sa[e]) * __builtin_amdgcn_rcpf(bf((unsigned short)sb[e]));
                            acc[ai][bj][m][1][e] *= bf((unsigned short)sa[4 + e]) * __builtin_amdgcn_rcpf(bf((unsigned short)sb[4 + e]));
                        }
                    } else {
                        f32x4 v0, v1;
#pragma unroll
                        for (int e = 0; e < 4; ++e) { v0[e] = acc[ai][bj][m][0][e] * bf((unsigned short)sb[e]); v1[e] = acc[ai][bj][m][1][e] * bf((unsigned short)sb[4 + e]); }
                        *(u32x4*)(O + off) = pack8(v0, v1);
                    }
                }
            }
    }
};

template <class Epi, class Sched, bool ALIGN_EPI = false, bool SP2 = false>
__device__ __forceinline__ void gemm_phase(PG8_LAS unsigned char* lds, const Gemm g, const Sched& S, const Epi& E) {
    int tid_ = threadIdx.x; asm volatile("" : "+v"(tid_));
    const int tid = tid_, wid = __builtin_amdgcn_readfirstlane(tid >> 6), lane = tid & 63, wr = wid >> 2, wc = wid & 3, fr = lane & 15, fq = lane >> 4;
    const int K = g.K, nt = K / BK;
    unsigned voffA[2], voffB[2];
#pragma unroll
    for (int i = 0; i < 2; ++i) { int R, C; stage_rc(tid * 16 + i * 8192, R, C); const int Rb = Epi::PERM ? ((R & ~31) + perm32(R & 31)) : R;
        voffA[i] = (unsigned)(R * K + C) * 2u; voffB[i] = (unsigned)(Rb * K + C) * 2u; }
    const size_t kstep = (size_t)(BK * 2);
    const size_t hstep = (size_t)HALF * K * 2;
    const size_t tstep = 2 * hstep;
    const unsigned ldsw = (unsigned)wid * 1024u;
    const int aoff = lds_byte(wr * 64 + fr, fq * 8), boff = lds_byte(wc * 32 + fr, fq * 8);
#define PG8_SA(b, h) (((b) * 2 + (h)) * HTB)
#define PG8_SB(b, h) ((4 + (b) * 2 + (h)) * HTB)
#define PG8_STAGE(bufoff, gbase, voff) do { _Pragma("unroll") for (int _i = 0; _i < 2; ++_i) \
        __builtin_amdgcn_global_load_lds((const unsigned*)((const char*)(gbase) + (voff)[_i]), (PG8_LAS unsigned*)(lds + (bufoff) + ldsw + _i * 8192), 16, 0, 0); } while (0)
#define PG8_LDA(dst, b, h) do { _Pragma("unroll") for (int m = 0; m < 4; ++m) _Pragma("unroll") for (int k = 0; k < 2; ++k) dst[m][k] = *(const PG8_LAS bf16x8*)(lds + PG8_SA(b, h) + aoff + m * 2048 + k * 1024); } while (0)
#define PG8_LDB(dst, b, h) do { _Pragma("unroll") for (int n = 0; n < 2; ++n) _Pragma("unroll") for (int k = 0; k < 2; ++k) dst[n][k] = *(const PG8_LAS bf16x8*)(lds + PG8_SB(b, h) + boff + n * 2048 + k * 1024); } while (0)
#define PG8_MMA(ai, bj, At, Bt) do { __builtin_amdgcn_s_setprio(1); _Pragma("unroll") for (int m = 0; m < 4; ++m) _Pragma("unroll") for (int n = 0; n < 2; ++n) _Pragma("unroll") for (int k = 0; k < 2; ++k) \
        acc[ai][bj][m][n] = __builtin_amdgcn_mfma_f32_16x16x32_bf16(Bt[n][k], At[m][k], acc[ai][bj][m][n], 0, 0, 0); __builtin_amdgcn_s_setprio(0); } while (0)
#define PG8_WAIT_V(n) asm volatile("s_waitcnt vmcnt(" #n ")" ::: "memory")
#define PG8_WAIT_L(n) asm volatile("s_waitcnt lgkmcnt(" #n ")" ::: "memory")
#define PG8_BAR __builtin_amdgcn_s_barrier()
#define PG8_SCHED __builtin_amdgcn_sched_barrier(0)
    Unit cur, nxt; int ui = 0;
    if (!S.next(0, cur)) return;
    f32x4 acc[2][2][4][2];
#pragma unroll
    for (int a = 0; a < 2; ++a)
#pragma unroll
        for (int b = 0; b < 2; ++b)
#pragma unroll
            for (int m = 0; m < 4; ++m)
#pragma unroll
                for (int n = 0; n < 2; ++n) acc[a][b][m][n] = (f32x4){0.f, 0.f, 0.f, 0.f};
    bf16x8 At[4][2], B0[2][2], B1[2][2];
    const char* cA = (const char*)(cur.z ? g.A2 : g.A) + (size_t)cur.pm * tstep; const char* cB = (const char*)(cur.z ? g.Bt2 : g.Bt) + (size_t)cur.pn * tstep;
    S.a_ready(cur);
    if constexpr (SP2) {
        PG8_STAGE(PG8_SB(0, 0), cB, voffB); PG8_STAGE(PG8_SB(0, 1), cB + hstep, voffB); PG8_STAGE(PG8_SA(0, 0), cA, voffA); PG8_STAGE(PG8_SA(0, 1), cA + hstep, voffA);
        if (wr == 1) PG8_BAR;
        PG8_WAIT_V(2); PG8_BAR;
        PG8_STAGE(PG8_SB(1, 0), cB + kstep, voffB); PG8_STAGE(PG8_SA(1, 0), cA + kstep, voffA); PG8_STAGE(PG8_SB(1, 1), cB + hstep + kstep, voffB);
        PG8_WAIT_V(6); PG8_BAR;
    } else {
        PG8_STAGE(PG8_SB(0, 0), cB, voffB); PG8_STAGE(PG8_SA(0, 0), cA, voffA); PG8_STAGE(PG8_SB(0, 1), cB + hstep, voffB); PG8_STAGE(PG8_SA(0, 1), cA + hstep, voffA);
        if (wr == 1) PG8_BAR;
        PG8_WAIT_V(4); PG8_BAR;
        PG8_STAGE(PG8_SB(1, 0), cB + kstep, voffB); PG8_STAGE(PG8_SA(1, 0), cA + kstep, voffA); PG8_STAGE(PG8_SB(1, 1), cB + hstep + kstep, voffB);
        PG8_WAIT_V(6); PG8_BAR;
    }
    for (;;) {
        const bool has_next = S.next(ui + 1, nxt);
        const char* nA = has_next ? (const char*)(nxt.z ? g.A2 : g.A) + (size_t)nxt.pm * tstep : cA; const char* nB = has_next ? (const char*)(nxt.z ? g.Bt2 : g.Bt) + (size_t)nxt.pn * tstep : cB;
        for (int t = 0; t < nt; t += 2) {
            const bool last = (t == nt - 2);
            const char* a1 = cA + (size_t)(t + 1) * kstep;
            const char* a2 = last ? nA : cA + (size_t)(t + 2) * kstep; const char* b2 = last ? nB : cB + (size_t)(t + 2) * kstep;
            const char* a3 = a2 + kstep; const char* b3 = b2 + kstep;
            if (last && has_next) S.a_ready(nxt);
            if constexpr (SP2) {
            PG8_LDB(B0, 0, 0); PG8_LDB(B1, 0, 1); PG8_SCHED; PG8_LDA(At, 0, 0); PG8_STAGE(PG8_SA(1, 1), a1 + hstep, voffA);
            PG8_WAIT_V(8); PG8_WAIT_L(0); PG8_BAR; PG8_MMA(0, 0, At, B0); PG8_MMA(0, 1, At, B1); PG8_BAR; PG8_SCHED;
            PG8_LDA(At, 0, 1); PG8_STAGE(PG8_SB(0, 0), b2, voffB); PG8_STAGE(PG8_SB(0, 1), b2 + hstep, voffB); PG8_STAGE(PG8_SA(0, 0), a2, voffA);
            PG8_WAIT_V(8); PG8_WAIT_L(0); PG8_BAR; PG8_MMA(1, 0, At, B0); PG8_MMA(1, 1, At, B1); PG8_BAR; PG8_SCHED;
            PG8_LDB(B0, 1, 0); PG8_LDB(B1, 1, 1); PG8_SCHED; PG8_LDA(At, 1, 0); PG8_STAGE(PG8_SA(0, 1), a2 + hstep, voffA);
            PG8_WAIT_V(8); PG8_WAIT_L(0); PG8_BAR; PG8_MMA(0, 0, At, B0); PG8_MMA(0, 1, At, B1); PG8_BAR; PG8_SCHED;
            PG8_LDA(At, 1, 1); PG8_STAGE(PG8_SB(1, 0), b3, voffB); PG8_STAGE(PG8_SB(1, 1), b3 + hstep, voffB); PG8_STAGE(PG8_SA(1, 0), a3, voffA);
            PG8_WAIT_V(8); PG8_WAIT_L(0); PG8_BAR; PG8_MMA(1, 0, At, B0); PG8_MMA(1, 1, At, B1); PG8_BAR; PG8_SCHED;
            } else {
            PG8_LDB(B0, 0, 0); PG8_SCHED; PG8_LDA(At, 0, 0); PG8_STAGE(PG8_SA(1, 1), a1 + hstep, voffA);
            PG8_WAIT_L(8); PG8_BAR; PG8_WAIT_L(0); PG8_MMA(0, 0, At, B0); PG8_BAR; PG8_SCHED;
            PG8_LDB(B1, 0, 1); PG8_STAGE(PG8_SB(0, 0), b2, voffB);
            PG8_BAR; PG8_WAIT_L(0); PG8_MMA(0, 1, At, B1); PG8_BAR;
            PG8_LDA(At, 0, 1); PG8_STAGE(PG8_SA(0, 0), a2, voffA);
            PG8_BAR; PG8_WAIT_L(0); PG8_MMA(1, 0, At, B0); PG8_BAR; PG8_SCHED;
            PG8_STAGE(PG8_SB(0, 1), b2 + hstep, voffB);
            PG8_WAIT_V(6); PG8_BAR; PG8_MMA(1, 1, At, B1); PG8_BAR;
            PG8_LDB(B0, 1, 0); PG8_SCHED; PG8_LDA(At, 1, 0); PG8_STAGE(PG8_SA(0, 1), a2 + hstep, voffA);
            PG8_WAIT_L(8); PG8_BAR; PG8_WAIT_L(0); PG8_MMA(0, 0, At, B0); PG8_BAR; PG8_SCHED;
            PG8_LDB(B1, 1, 1); PG8_STAGE(PG8_SB(1, 0), b3, voffB);
            PG8_BAR; PG8_WAIT_L(0); PG8_MMA(0, 1, At, B1); PG8_BAR;
            PG8_LDA(At, 1, 1); PG8_STAGE(PG8_SA(1, 0), a3, voffA);
            PG8_BAR; PG8_WAIT_L(0); PG8_MMA(1, 0, At, B0); PG8_BAR; PG8_SCHED;
            PG8_STAGE(PG8_SB(1, 1), b3 + hstep, voffB);
            PG8_WAIT_V(6); PG8_BAR; PG8_MMA(1, 1, At, B1); PG8_BAR;
            }
        }
        if constexpr (ALIGN_EPI) { if (wr == 0) PG8_BAR; }
        if constexpr (!Epi::AFTER_DRAIN) { E(acc, cur, wr, wc, fr, fq); S.done(cur); }
        if (!has_next) break;
        if (!E.keep(cur)) {
#pragma unroll
        for (int a = 0; a < 2; ++a)
#pragma unroll
            for (int b = 0; b < 2; ++b)
#pragma unroll
                for (int m = 0; m < 4; ++m)
#pragma unroll
                    for (int n = 0; n < 2; ++n) acc[a][b][m][n] = (f32x4){0.f, 0.f, 0.f, 0.f};
        }
        cur = nxt; cA = nA; cB = nB; ++ui;
        if constexpr (ALIGN_EPI) { if (wr == 1) PG8_BAR; }
    }
    PG8_WAIT_V(0);
    if constexpr (!ALIGN_EPI) { if (wr == 0) PG8_BAR; }
    PG8_BAR;
    if constexpr (Epi::AFTER_DRAIN) { E.fused(acc, cur, wr, wc, fr, fq, lds, wid, lane); S.done(cur); }
#undef PG8_SA
#undef PG8_SB
#undef PG8_STAGE
#undef PG8_LDA
#undef PG8_LDB
#undef PG8_MMA
#undef PG8_WAIT_V
#undef PG8_WAIT_L
#undef PG8_BAR
#undef PG8_SCHED
}
}

#define GAS __attribute__((address_space(1)))
#define LAS __attribute__((address_space(3)))
typedef unsigned short bf16;
typedef unsigned v4u __attribute__((ext_vector_type(4)));
typedef float f32x4 __attribute__((ext_vector_type(4)));
typedef short bf16x8 __attribute__((ext_vector_type(8)));
typedef GAS unsigned gu32;
typedef GAS unsigned long long gu64;
#define RLX_AGENT __ATOMIC_RELAXED, __HIP_MEMORY_SCOPE_AGENT
#define LDS_WAIT() asm volatile("s_waitcnt lgkmcnt(0)" ::: "memory")
#define VM_WAIT() asm volatile("s_waitcnt vmcnt(0)" ::: "memory")
__device__ __forceinline__ unsigned long long rt() { return __builtin_amdgcn_s_memrealtime(); }
__device__ __forceinline__ unsigned f2bf(float f) { unsigned u = __builtin_bit_cast(unsigned, f); return (u + 0x7fffu + ((u >> 16) & 1u)) >> 16; }
typedef float f32x2_pk __attribute__((ext_vector_type(2))); typedef __bf16 bf16x2_pk __attribute__((ext_vector_type(2)));
__device__ __forceinline__ unsigned pk2(float lo, float hi) { f32x2_pk v = {lo, hi}; bf16x2_pk b = __builtin_convertvector(v, bf16x2_pk); return __builtin_bit_cast(unsigned, b); }

#define XB_TMO      128
#define XB_XCNT(j)  (256  + 64 * (j))
#define XB_XSUB(j)  (1280 + 64 * (j))
#define XB_XGEN(j)  (2304 + 64 * (j))
#define XB_TOP      3328
#define XB_TOPGEN   3392
#define XCD_BAR_WORDS 3456
#define XB_SPIN_CAP (1u << 25)

__device__ __forceinline__ unsigned xb_ld(unsigned* p)              { return __hip_atomic_load(p, __ATOMIC_RELAXED, __HIP_MEMORY_SCOPE_AGENT); }
__device__ __forceinline__ unsigned xb_add(unsigned* p, unsigned v) { return __hip_atomic_fetch_add(p, v, __ATOMIC_RELAXED, __HIP_MEMORY_SCOPE_AGENT); }
__device__ __forceinline__ unsigned xb_xcc_id() { return (unsigned)__builtin_amdgcn_s_getreg((3 << 11) | 20) & 0xFu; }
#define XB_SPIN(cond, bar) do { unsigned _sp = 0; while (cond) { __builtin_amdgcn_s_sleep(1); \
    if ((++_sp & 255u) == 0u) { if (xb_ld(&(bar)[XB_TMO])) break; if (_sp > XB_SPIN_CAP) { atomicAdd(&(bar)[XB_TMO], 1u); break; } } } } while (0)

struct XcdBarrier {
    unsigned* bar; unsigned x;
    volatile LAS unsigned* st;
};

__device__ __forceinline__ XcdBarrier xcd_barrier_post(unsigned* bar, volatile LAS unsigned* st) {
    XcdBarrier b; b.bar = bar; b.x = xb_xcc_id(); b.st = st;
    if (threadIdx.x == 0) (void)xb_add(&bar[XB_XCNT(b.x)], 1u);
    return b;
}
__device__ __forceinline__ void xcd_barrier_complete(unsigned* bar, unsigned x, unsigned& nloc, unsigned& nx) {
    const unsigned G = gridDim.x * gridDim.y * gridDim.z;
    unsigned sum, cnt, mine, sp = 0u;
    for (;;) {
        sum = 0u; cnt = 0u; mine = 0u;
#pragma unroll
        for (unsigned j = 0; j < 16; ++j) { const unsigned c = xb_ld(&bar[XB_XCNT(j)]); sum += c; cnt += (c > 0u) ? 1u : 0u; mine = (j == x) ? c : mine; }
        if (sum == G) break;
        __builtin_amdgcn_s_sleep(1);
        if ((++sp & 255u) == 0u) { if (xb_ld(&bar[XB_TMO])) break; if (sp > XB_SPIN_CAP) { atomicAdd(&bar[XB_TMO], 1u); break; } }
    }
    nloc = mine > 0u ? mine : 1u; nx = cnt > 0u ? cnt : 1u;
}

__device__ __forceinline__ void xcd_barrier(const XcdBarrier& b) {
    asm volatile("s_waitcnt vmcnt(0)" ::: "memory");
    __syncthreads();
    if (threadIdx.x == 0) {
        unsigned* bar = b.bar;
        __builtin_amdgcn_s_waitcnt(0);
        unsigned nloc = b.st[0], nx = b.st[1];
        if (nloc == 0u) { xcd_barrier_complete(bar, b.x, nloc, nx); b.st[0] = nloc; b.st[1] = nx; }
        const unsigned old = xb_add(&bar[XB_XSUB(b.x)], 1u);
        const unsigned gen = old / nloc;
        if (old + 1u == (gen + 1u) * nloc) {
            __builtin_amdgcn_fence(__ATOMIC_RELEASE, "agent");
            asm volatile("s_waitcnt vmcnt(0)" ::: "memory");
            const unsigned og = xb_add(&bar[XB_TOP], 1u);
            const unsigned tg = og / nx;
            if (og + 1u == (tg + 1u) * nx) xb_add(&bar[XB_TOPGEN], 1u);
            else XB_SPIN(xb_ld(&bar[XB_TOPGEN]) == tg, bar);
            __builtin_amdgcn_fence(__ATOMIC_ACQUIRE, "agent");
            xb_add(&bar[XB_XGEN(b.x)], 1u);
            asm volatile("s_waitcnt vmcnt(0)" ::: "memory");
        } else {
            XB_SPIN(xb_ld(&bar[XB_XGEN(b.x)]) == gen, bar);
            __builtin_amdgcn_fence(__ATOMIC_ACQUIRE, "agent");
            asm volatile("s_waitcnt vmcnt(0)" ::: "memory");
        }
    }
    __syncthreads();
}


constexpr int NWAVES = 8;
constexpr int DM = 1024, DFF = 2816, NREAL = 16384, NROWS = 16640  , TSEQ = 8192, NMETA = 16, KVR = 8320  ;
constexpr int NCT_WIN = 35;
constexpr int MASKW = 260;
constexpr size_t MiB = 1u << 20, QMiB = 1u << 18;
constexpr size_t WS_CTL = 0, CTL_ZERO_BYTES = 1 * MiB;
constexpr size_t WS_SSQA = 4 * QMiB, WS_SSQB = 9 * QMiB, WS_SSQC = 14 * QMiB, WS_METAH = 19 * QMiB, WS_BIAST = 19 * QMiB + 65536, WS_GLR = 20 * QMiB, WS_IW = 25 * QMiB, WS_DBUF = 27 * QMiB;
constexpr size_t WS_W1GU = 8 * MiB, WS_W1D = 19 * MiB, WS_WIN = 98 * QMiB, WS_WA = 42 * MiB, WS_WB = 44 * MiB, WS_WO = 46 * MiB, WS_W2GU = 48 * MiB, WS_W2D = 59 * MiB;
constexpr size_t WS_MASK = 8 * MiB;
constexpr size_t WS_XN = 65 * MiB;
constexpr size_t WS_HB = 98 * MiB;
constexpr size_t WS_GQ = 98 * MiB, WS_GK = 114 * MiB, WS_GV = 521 * QMiB, WS_GR = 651 * QMiB, WS_LBUF = 195 * MiB, WS_TT = 8 * MiB, WS_IKB = 911 * QMiB, WS_IQ = 230 * MiB;
constexpr size_t WS_DQ = 98 * MiB, WS_DKB = 130 * MiB, WS_DVB = 212 * MiB;
constexpr size_t WS_GA = 130 * MiB, WS_GB = 212 * MiB;
constexpr size_t WS_A3 = 98 * MiB, WS_HB2 = 130 * MiB;
constexpr size_t WS_END = 256 * MiB;
static_assert(WS_WIN + (size_t)NCT_WIN * 256 * 1024 * 2 <= WS_WA && WS_W2D + (size_t)1024 * DFF * 2 <= WS_XN && WS_XN + (size_t)NROWS * 1024 * 2 <= WS_HB, "ws map 1");
static_assert(WS_HB + (size_t)NROWS * DFF * 2 <= WS_END && WS_GR + (size_t)NREAL * 1024 * 2 <= WS_LBUF && WS_GV + (size_t)NROWS * 1024 * 2 <= WS_GR && WS_GK + (size_t)NROWS * 512 * 2 <= WS_GV, "ws map 2");
static_assert(WS_LBUF + (size_t)260 * 131072 <= WS_IKB && WS_TT + (size_t)256 * 65536 <= WS_WIN && WS_IKB + (size_t)2 * KVR * 64 * 2 <= WS_IQ && WS_IQ + (size_t)NREAL * 512 * 2 <= WS_END, "ws map 3");
static_assert(WS_DKB + (size_t)2 * KVR * 1024 * 2 <= WS_GR && WS_DVB + (size_t)2 * KVR * 1024 * 2 <= WS_END && WS_MASK + (size_t)NREAL * MASKW * 4 <= WS_WIN && WS_HB2 + (size_t)NREAL * DFF * 2 <= WS_END, "ws map 4");
static_assert(WS_SSQA + (size_t)NROWS * 64 <= WS_SSQB && WS_SSQB + (size_t)NROWS * 64 <= WS_SSQC && WS_SSQC + (size_t)NROWS * 64 <= WS_METAH && WS_GLR + (size_t)NROWS * 64 <= WS_IW && WS_IW + (size_t)NREAL * 32 <= WS_DBUF && WS_DBUF + 260 * 512 <= WS_W1GU, "ws map 5");
constexpr int CW_TMO = 0, CW_CODE = 1, CW_BAR = 4096, CW_QUEUE = 16384;

constexpr int RING_OFF = 0, RING_BYTES = 131072;
constexpr int LDSCTL_OFF = RING_BYTES, MISC_OFF = LDSCTL_OFF + 320;
constexpr int LDS_BYTES = 147456;

struct Frame {
    LAS unsigned char* lds;
    volatile LAS unsigned* MISC;
    gu32* ctl;
    int vcu, G;
    unsigned char* ws;
    const float *x, *meta, *n1, *w1g, *w1u, *w1d, *nm, *win, *wlr, *blr, *gn, *wa, *wb, *wo, *rb, *n2, *w2g, *w2u, *w2d, *nf;
    float* out;
};
__device__ __forceinline__ float wave_sum(float v) {
#pragma unroll
    for (int o = 1; o < 64; o <<= 1) v += __shfl_xor(v, o);
    return v;
}
__device__ __forceinline__ float bf2f(unsigned short x) { return __builtin_bit_cast(float, (unsigned)x << 16); }

__device__ __forceinline__ int fresh_tid() { int t = threadIdx.x; asm volatile("" : "+v"(t)); return t; }


template <class F>
__device__ __forceinline__ void p0_transpose_item(const float* W, int Nsrc, int K, bf16* WT, int nblk, LAS float* scr, int item, int lane, F srccol) {
    const int kb = item / nblk, nb = item % nblk, k0 = 64 * kb, n0 = 32 * nb;
    const int sc = srccol(n0 + (lane & 31));
#pragma unroll 8
    for (int i = 0; i < 32; ++i) { const int kk = 2 * i + (lane >> 5); scr[kk * 33 + (lane & 31)] = sc >= 0 ? W[(size_t)(k0 + kk) * Nsrc + sc] : 0.f; }
    LDS_WAIT(); asm volatile("" ::: "memory");
    const int c = lane & 7;
#pragma unroll
    for (int j = 0; j < 4; ++j) { const int n = (lane >> 3) + 8 * j; const LAS float* s = scr + (8 * c) * 33 + n;
        v4u o; o.x = pk2(s[0 * 33], s[1 * 33]); o.y = pk2(s[2 * 33], s[3 * 33]); o.z = pk2(s[4 * 33], s[5 * 33]); o.w = pk2(s[6 * 33], s[7 * 33]);
        *(GAS v4u*)(WT + (size_t)(n0 + n) * K + k0 + 8 * c) = o; }
    LDS_WAIT(); asm volatile("" ::: "memory");
}
__device__ __forceinline__ int win_src(int n) {
    const int ct = n >> 8, r = n & 255;
    if (ct < 2) return 0 + (ct - 0) * 256 + r;
    if (ct < 4) return 512 + (ct - 2) * 256 + r;
    if (ct < 8) return 1024 + (ct - 4) * 256 + r;
    if (ct < 12) return 2048 + (ct - 8) * 256 + r;
    if (ct < 14) return 6160 + (ct - 12) * 256 + r;
    if (ct == 14) return r < 16 ? 3072 + r : (r < 80 ? 6672 + (r - 16) : (r < 88 ? 6736 + (r - 80) : -1));
    if (ct < 19) return 3088 + (ct - 15) * 256 + r;
    if (ct < 23) return 4112 + (ct - 19) * 256 + r;
    if (ct < 27) return 5136 + (ct - 23) * 256 + r;
    if (ct < 31) return 6744 + (ct - 27) * 256 + r;
    return 7768 + (ct - 31) * 256 + r;
}
__device__ __forceinline__ void rms_row_to_bf16(const float* xrow, const float* gain, bf16* orow, int lane) {
    const GAS f32x4* xr = (const GAS f32x4*)xrow + lane; const GAS f32x4* gr = (const GAS f32x4*)gain + lane;
    f32x4 v[4]; float s = 0.f;
#pragma unroll
    for (int j = 0; j < 4; ++j) { v[j] = xr[64 * j]; s += (v[j].x * v[j].x + v[j].y * v[j].y) + (v[j].z * v[j].z + v[j].w * v[j].w); }
    const float rstd = 1.f / sqrtf(wave_sum(s) * (1.f / 1024.f) + 1e-6f);
    GAS unsigned long long* o8 = (GAS unsigned long long*)orow + lane;
#pragma unroll
    for (int j = 0; j < 4; ++j) { const f32x4 g = gr[64 * j];
        o8[64 * j] = (unsigned long long)pk2(v[j].x * rstd * g.x, v[j].y * rstd * g.y) | ((unsigned long long)pk2(v[j].z * rstd * g.z, v[j].w * rstd * g.w) << 32); }
}
__device__ __forceinline__ int rel_bucket_dev(int n) {
    if (n < 16) return n;
    const float nf = (float)n;
    int large = 16 + (int)(logf(nf / 16.0f) / 2.0794415416798357f * 16.0f);
    return large < 31 ? large : 31;
}
__device__ __forceinline__ void p0_prologue(Frame& F) {
    const int tid = fresh_tid(), lane = tid & 63, wave = __builtin_amdgcn_readfirstlane(tid >> 6);
    LAS float* scr = (LAS float*)(F.lds + RING_OFF + wave * 16384);
    const int gw = F.vcu * NWAVES + wave, NGW = F.G * NWAVES;
    unsigned char* ws = F.ws;
    constexpr int I_GU = (1024 / 64) * (5632 / 32), I_D = (2816 / 64) * (1024 / 32), I_WIN = (1024 / 64) * (NCT_WIN * 256 / 32), I_SQ = (1024 / 64) * (1024 / 32);
    constexpr int NITEMS = 2 * I_GU + 2 * I_D + I_WIN + 3 * I_SQ;
    for (int it = gw; it < NITEMS; it += NGW) {
        int r = it;
        if (r < I_GU) { const float* g = F.w1g; const float* u = F.w1u; const int nb = r % (5632 / 32); const bool up = ((nb * 32) & 128) != 0;
            p0_transpose_item(up ? u : g, DFF, 1024, (bf16*)(ws + WS_W1GU), 5632 / 32, scr, r, lane, [](int n) { return (n >> 8) * 128 + (n & 127); }); continue; } r -= I_GU;
        if (r < I_GU) { const float* g = F.w2g; const float* u = F.w2u; const int nb = r % (5632 / 32); const bool up = ((nb * 32) & 128) != 0;
            p0_transpose_item(up ? u : g, DFF, 1024, (bf16*)(ws + WS_W2GU), 5632 / 32, scr, r, lane, [](int n) { return (n >> 8) * 128 + (n & 127); }); continue; } r -= I_GU;
        if (r < I_D) { p0_transpose_item(F.w1d, 1024, DFF, (bf16*)(ws + WS_W1D), 1024 / 32, scr, r, lane, [](int n) { return n; }); continue; } r -= I_D;
        if (r < I_D) { p0_transpose_item(F.w2d, 1024, DFF, (bf16*)(ws + WS_W2D), 1024 / 32, scr, r, lane, [](int n) { return n; }); continue; } r -= I_D;
        if (r < I_WIN) { p0_transpose_item(F.win, 8792, 1024, (bf16*)(ws + WS_WIN), NCT_WIN * 256 / 32, scr, r, lane, [](int n) { return win_src(n); }); continue; } r -= I_WIN;
        if (r < I_SQ) { p0_transpose_item(F.wa, 1024, 1024, (bf16*)(ws + WS_WA), 32, scr, r, lane, [](int n) { return n; }); continue; } r -= I_SQ;
        if (r < I_SQ) { p0_transpose_item(F.wb, 1024, 1024, (bf16*)(ws + WS_WB), 32, scr, r, lane, [](int n) { return n; }); continue; } r -= I_SQ;
        p0_transpose_item(F.wo, 1024, 1024, (bf16*)(ws + WS_WO), 32, scr, r, lane, [](int n) { return n; });
    }
    bf16* XN = (bf16*)(ws + WS_XN);
    for (int m = gw; m < NREAL + NMETA; m += NGW)
        rms_row_to_bf16(m < NREAL ? F.x + (size_t)m * DM : F.meta + (size_t)(m - NREAL) * DM, F.n1, XN + (size_t)m * DM, lane);
    if (blockIdx.x == 0) {
        if (tid < 256) ((float*)(ws + WS_SSQA))[(size_t)NREAL * 16 + tid] = 0.f;
        float* bt = (float*)(ws + WS_BIAST);
        for (int i = tid; i < 8 * 128; i += NWAVES * 64) { const int h = i >> 7, d = i & 127; bt[i] = (F.rb[rel_bucket_dev(d) * 8 + h] - F.rb[31 * 8 + h]) * 1.4426950408889634f; }
    }
}
__device__ __forceinline__ void p_final(Frame& F, const float* ssq) {
    const int tid = fresh_tid(), lane = tid & 63, wave = __builtin_amdgcn_readfirstlane(tid >> 6);
    const int gw = F.vcu * NWAVES + wave, NGW = F.G * NWAVES;
    for (int m = gw; m < NREAL; m += NGW) {
        const float rs = pg8::rstd_row(ssq, m);
        GAS f32x4* xr = (GAS f32x4*)(F.out + (size_t)m * DM) + lane; const GAS f32x4* gr = (const GAS f32x4*)F.nf + lane;
#pragma unroll
        for (int j = 0; j < 4; ++j) { const f32x4 v = xr[64 * j], g = gr[64 * j]; xr[64 * j] = v * rs * g; }
    }
}


typedef float f32x4m __attribute__((ext_vector_type(4)));
typedef short s16x8m __attribute__((ext_vector_type(8)));
template <int K, int U>
__device__ __forceinline__ f32x4m meta_tile(const bf16* A16, const bf16* B16, int lane) {
    const bf16* ap = A16 + (size_t)(lane & 15) * K + 8 * (lane >> 4);
    const bf16* bp = B16 + (size_t)(lane & 15) * K + 8 * (lane >> 4);
    f32x4m acc = (f32x4m){0.f, 0.f, 0.f, 0.f};
    static_assert((K / 32) % U == 0, "meta_tile batch");
    for (int k0 = 0; k0 < K / 32; k0 += U) {
        s16x8m a[U], b[U];
#pragma unroll
        for (int i = 0; i < U; ++i) { a[i] = *(const s16x8m*)(ap + 32 * (k0 + i)); b[i] = *(const s16x8m*)(bp + 32 * (k0 + i)); }
#pragma unroll
        for (int i = 0; i < U; ++i) acc = __builtin_amdgcn_mfma_f32_16x16x32_bf16(a[i], b[i], acc, 0, 0, 0);
    }
    return acc;
}
__device__ __forceinline__ float silu_m(float x) { return x * __builtin_amdgcn_rcpf(1.f + __builtin_amdgcn_exp2f(-1.4426950408889634f * x)); }
__device__ __forceinline__ void meta_ffn1_gu(Frame& F, int first) {
    const int tid = fresh_tid(), lane = tid & 63, wave = __builtin_amdgcn_readfirstlane(tid >> 6);
    const bf16* XNm = (const bf16*)(F.ws + WS_XN) + (size_t)NREAL * 1024; const bf16* W = (const bf16*)(F.ws + WS_W1GU); bf16* HBm = (bf16*)(F.ws + WS_HB) + (size_t)NREAL * DFF;
    if ((int)blockIdx.x >= first) for (int t = ((int)blockIdx.x - first) * NWAVES + wave; t < DFF / 16; t += (F.G - first) * NWAVES) {
        const int hc0 = 16 * t, pn = hc0 >> 7, w0 = hc0 & 127;
        const f32x4m g = meta_tile<1024, 16>(XNm, W + (size_t)(pn * 256 + w0) * 1024, lane);
        const f32x4m u = meta_tile<1024, 16>(XNm, W + (size_t)(pn * 256 + 128 + w0) * 1024, lane);
#pragma unroll
        for (int i = 0; i < 4; ++i) HBm[(size_t)(4 * (lane >> 4) + i) * DFF + hc0 + (lane & 15)] = (bf16)f2bf(silu_m(g[i]) * u[i]);
    }
}
__device__ __forceinline__ void meta_ffn1_down(Frame& F, int first) {
    const int tid = fresh_tid(), lane = tid & 63, wave = __builtin_amdgcn_readfirstlane(tid >> 6);
    const bf16* HBm = (const bf16*)(F.ws + WS_HB) + (size_t)NREAL * DFF; const bf16* W = (const bf16*)(F.ws + WS_W1D);
    float* MH = (float*)(F.ws + WS_METAH); bf16* XNm = (bf16*)(F.ws + WS_XN) + (size_t)NREAL * 1024; float* SS = (float*)(F.ws + WS_SSQA) + (size_t)NREAL * 16;
    if ((int)blockIdx.x >= first) for (int t = ((int)blockIdx.x - first) * NWAVES + wave; t < 1024 / 16; t += (F.G - first) * NWAVES) {
        const f32x4m a = meta_tile<DFF, 22>(HBm, W + (size_t)(16 * t) * DFF, lane);
        const int c = 16 * t + (lane & 15); const float gn = F.nm[c];
#pragma unroll
        for (int i = 0; i < 4; ++i) { const int r = 4 * (lane >> 4) + i; const float h = F.meta[r * 1024 + c] + 0.5f * a[i];
            MH[r * 1024 + c] = h; XNm[(size_t)r * 1024 + c] = (bf16)f2bf(h * gn);
            float ss = h * h; ss += __shfl_xor(ss, 1); ss += __shfl_xor(ss, 2); ss += __shfl_xor(ss, 4); ss += __shfl_xor(ss, 8);
            if ((lane & 15) == 0) atomicAdd(SS + r * 16 + (t & 15), ss); }
    }
}
__device__ __forceinline__ float meta_rstd(const float* ssq, int r) { return pg8::rstd_row(ssq, NREAL + r); }
__device__ __forceinline__ void meta_win_a(Frame& F, int first) {
    const int tid = fresh_tid(), lane = tid & 63, wave = __builtin_amdgcn_readfirstlane(tid >> 6);
    const bf16* XNm = (const bf16*)(F.ws + WS_XN) + (size_t)NREAL * 1024; const bf16* W = (const bf16*)(F.ws + WS_WIN); const float* SSQ = (const float*)(F.ws + WS_SSQA);
    bf16* GK = (bf16*)(F.ws + WS_GK); bf16* GV = (bf16*)(F.ws + WS_GV); float* GLR = (float*)(F.ws + WS_GLR); bf16* IK = (bf16*)(F.ws + WS_IKB);
    if ((int)blockIdx.x >= first) for (int t = ((int)blockIdx.x - first) * NWAVES + wave; t < 102; t += (F.G - first) * NWAVES) {
        const int kind = t < 32 ? 0 : (t < 96 ? 1 : 2), tt = kind == 0 ? t : (kind == 1 ? t - 32 : t - 96);
        const int wrow = (kind == 0 ? 2 * 256 : (kind == 1 ? 4 * 256 : 14 * 256)) + 16 * tt;
        const f32x4m a = meta_tile<1024, 16>(XNm, W + (size_t)wrow * 1024, lane);
        const int c = 16 * tt + (lane & 15);
#pragma unroll
        for (int i = 0; i < 4; ++i) { const int r = 4 * (lane >> 4) + i; const float v = a[i] * meta_rstd(SSQ, r);
            if (kind == 0) GK[(size_t)(NREAL + r) * 512 + c] = (bf16)f2bf(v);
            else if (kind == 1) GV[(size_t)(NREAL + r) * 1024 + c] = (bf16)f2bf(v);
            else if (c < 16) GLR[(size_t)(NREAL + r) * 16 + c] = v;
            else if (c < 80) { IK[(size_t)r * 64 + c - 16] = (bf16)f2bf(v); IK[(size_t)(KVR + r) * 64 + c - 16] = (bf16)f2bf(v); } }
    }
}
__device__ __forceinline__ void meta_win_b(Frame& F, int first) {
    const int tid = fresh_tid(), lane = tid & 63, wave = __builtin_amdgcn_readfirstlane(tid >> 6);
    const bf16* XNm = (const bf16*)(F.ws + WS_XN) + (size_t)NREAL * 1024; const bf16* W = (const bf16*)(F.ws + WS_WIN); const float* SSQ = (const float*)(F.ws + WS_SSQA);
    bf16* DK = (bf16*)(F.ws + WS_DKB); bf16* DV = (bf16*)(F.ws + WS_DVB);
    if ((int)blockIdx.x >= first) for (int t = ((int)blockIdx.x - first) * NWAVES + wave; t < 128; t += (F.G - first) * NWAVES) {
        const int kind = t >> 6, tt = t & 63;
        const f32x4m a = meta_tile<1024, 16>(XNm, W + (size_t)((kind ? 23 : 19) * 256 + 16 * tt) * 1024, lane);
        const int c = 16 * tt + (lane & 15); bf16* P = kind ? DV : DK;
#pragma unroll
        for (int i = 0; i < 4; ++i) { const int r = 4 * (lane >> 4) + i; const bf16 v = (bf16)f2bf(a[i] * meta_rstd(SSQ, r));
            P[(size_t)r * 1024 + c] = v; P[(size_t)(KVR + r) * 1024 + c] = v; }
    }
}


typedef short s16x8 __attribute__((ext_vector_type(8)));
typedef short s16x4v __attribute__((ext_vector_type(4)));
typedef float f32x16 __attribute__((ext_vector_type(16)));
typedef unsigned u32x2 __attribute__((ext_vector_type(2)));
typedef float f32x2 __attribute__((ext_vector_type(2)));
__device__ __forceinline__ int crow16(int r, int hi) { return (r & 3) + 8 * (r >> 2) + 4 * hi; }
__device__ __forceinline__ s16x4v ldtr(const LAS unsigned char* p) { return __builtin_bit_cast(s16x4v, __builtin_amdgcn_ds_read_tr16_b64_v4i16((LAS s16x4v*)p)); }
__device__ __forceinline__ s16x8 cat8(s16x4v a, s16x4v b) { return (s16x8){a[0], a[1], a[2], a[3], b[0], b[1], b[2], b[3]}; }
__device__ __forceinline__ float logsigmoid_f(float x) { return fminf(x, 0.f) - __logf(1.f + __expf(-fabsf(x))); }

constexpr int GLA_QT = 0, GLA_KT = 17408, GLA_QH = 34816, GLA_VS = 52224, GLA_AM = 86016, GLA_EBL = 95232, GLA_GLR = 95744, GLA_PART = 99840;
constexpr int PQ = 272, PV = 528, PA = 144;
constexpr int GLA_NSC = 32, GLA_NCH = 4, GLA_NU = 8 * GLA_NSC;

__device__ __forceinline__ void gla_phase_a(Frame& F, bool dry, int variant = 0) {
    unsigned char* ws = F.ws;
    bf16* GQ = (bf16*)(ws + WS_GQ); bf16* GK = (bf16*)(ws + WS_GK); bf16* GV = (bf16*)(ws + WS_GV);
    const float* GLR = (const float*)(ws + WS_GLR); float* LBUF = (float*)(ws + WS_LBUF); float* DBUF = (float*)(ws + WS_DBUF);
    LAS unsigned char* L = F.lds + RING_OFF;
    const int tid = fresh_tid(), lane = tid & 63, w = __builtin_amdgcn_readfirstlane(tid >> 6), hi = lane >> 5, l31 = lane & 31;
    const int d0 = 2 * lane;
    const int srow = tid >> 3, sseg = tid & 7;
    for (int u = F.vcu; u < GLA_NU + 4; u += F.G) {
        const bool meta = u >= GLA_NU;
        const int b = meta ? 0 : (u >> 7), h = meta ? (u - GLA_NU) : ((u >> 5) & 3), j = meta ? 0 : (u & 31);
        const float bl0 = F.blr[128 * h + d0], bl1 = F.blr[128 * h + d0 + 1];
        float Bs0 = 0.f, Bs1 = 0.f;
        f32x16 S[4];
#pragma unroll
        for (int dt = 0; dt < 4; ++dt) S[dt] = (f32x16){};
        const int nch = meta ? 1 : GLA_NCH, ntok = meta ? 16 : 64;
        for (int c = 0; c < nch; ++c) {
            const int row0 = meta ? NREAL : (b * TSEQ + 256 * j + 64 * c);
            { const bool ok = srow < ntok; const int rs_ = row0 + (ok ? srow : 0);
              const v4u z = (v4u){0u, 0u, 0u, 0u};
              v4u xq[2], xk[2], xv[4];
#pragma unroll
              for (int e = 0; e < 2; ++e) { xk[e] = *(const v4u*)(GK + (size_t)rs_ * 512 + 128 * h + 16 * sseg + 8 * e); xq[e] = *(const v4u*)(GQ + (size_t)(meta ? 0 : rs_) * 512 + 128 * h + 16 * sseg + 8 * e); }
#pragma unroll
              for (int e = 0; e < 4; ++e) xv[e] = *(const v4u*)(GV + (size_t)rs_ * 1024 + 256 * h + 32 * sseg + 8 * e);
              const int gt_ = (tid >> 2) & 63; const bool gok = gt_ < ntok;
              const f32x4 g4 = *(const f32x4*)(GLR + (size_t)(row0 + (gok ? gt_ : 0)) * 16 + 4 * (tid & 3));
#pragma unroll
              for (int e = 0; e < 2; ++e) { *(LAS v4u*)(L + GLA_QT + srow * PQ + (16 * sseg + 8 * e) * 2) = (ok && !meta) ? xq[e] : z; *(LAS v4u*)(L + GLA_KT + srow * PQ + (16 * sseg + 8 * e) * 2) = ok ? xk[e] : z; }
#pragma unroll
              for (int e = 0; e < 4; ++e) *(LAS v4u*)(L + GLA_VS + srow * PV + (32 * sseg + 8 * e) * 2) = ok ? xv[e] : z;
              if (tid < 256) *(LAS f32x4*)(L + GLA_GLR + tid * 16) = gok ? g4 : (f32x4){0.f, 0.f, 0.f, 0.f}; }
            __syncthreads();
            float c0[8], c1[8]; float r0 = 0.f, r1 = 0.f;
#pragma unroll
            for (int tt = 0; tt < 8; ++tt) { c0[tt] = 0.f; c1[tt] = 0.f; }
            if (variant != 1) { float wl0[16], wl1[16];
#pragma unroll
              for (int i = 0; i < 16; ++i) { const f32x2 wv = *(const f32x2*)(F.wlr + i * 512 + 128 * h + d0); wl0[i] = wv[0]; wl1[i] = wv[1]; }
#pragma unroll
              for (int tt = 0; tt < 8; ++tt) { const int t = 8 * w + tt; float x0 = bl0, x1 = bl1;
#pragma unroll
                  for (int i4 = 0; i4 < 4; ++i4) { const f32x4 g4 = *(const LAS f32x4*)(L + GLA_GLR + t * 64 + i4 * 16);
#pragma unroll
                      for (int e = 0; e < 4; ++e) { x0 += g4[e] * wl0[4 * i4 + e]; x1 += g4[e] * wl1[4 * i4 + e]; } }
                  const bool okt = t < ntok;
                  r0 += okt ? logsigmoid_f(x0) * (1.0f / 16.0f) : 0.f; r1 += okt ? logsigmoid_f(x1) * (1.0f / 16.0f) : 0.f; c0[tt] = r0; c1[tt] = r1; } }
            *(LAS f32x2*)(L + GLA_PART + (w * 128 + d0) * 4) = (f32x2){r0, r1};
            __syncthreads();
            float p0 = 0.f, p1 = 0.f, t0 = 0.f, t1 = 0.f;
#pragma unroll
            for (int g8 = 0; g8 < 8; ++g8) { const f32x2 pv = *(const LAS f32x2*)(L + GLA_PART + (g8 * 128 + d0) * 4); t0 += pv[0]; t1 += pv[1]; if (g8 < w) { p0 += pv[0]; p1 += pv[1]; } }
            const float es0 = __expf(Bs0), es1 = __expf(Bs1);
#pragma unroll
            for (int tt = 0; tt < 8; ++tt) { const int t = 8 * w + tt; const float b0 = p0 + c0[tt], b1 = p1 + c1[tt];
                const unsigned qx = *(const LAS unsigned*)(L + GLA_QT + t * PQ + d0 * 2), kx = *(const LAS unsigned*)(L + GLA_KT + t * PQ + d0 * 2);
                const float q0 = bf2f((unsigned short)(qx & 0xffff)) * __expf(b0), q1 = bf2f((unsigned short)(qx >> 16)) * __expf(b1);
                const float k0 = bf2f((unsigned short)(kx & 0xffff)) * __expf(-b0), k1 = bf2f((unsigned short)(kx >> 16)) * __expf(-b1);
                *(LAS unsigned*)(L + GLA_QT + t * PQ + d0 * 2) = pk2(q0, q1); *(LAS unsigned*)(L + GLA_KT + t * PQ + d0 * 2) = pk2(k0, k1);
                *(LAS unsigned*)(L + GLA_QH + t * PQ + d0 * 2) = pk2(q0 * es0, q1 * es1); }
            if (w == 0) *(LAS f32x2*)(L + GLA_EBL + d0 * 4) = (f32x2){__expf(t0), __expf(t1)};
            Bs0 += t0; Bs1 += t1;
            __syncthreads();
            if (!meta && !dry) {
#pragma unroll
                for (int e = 0; e < 2; ++e) *(v4u*)(GQ + (size_t)(row0 + srow) * 512 + 128 * h + 16 * sseg + 8 * e) = *(const LAS v4u*)(L + GLA_QH + srow * PQ + (16 * sseg + 8 * e) * 2);
            }
            if (w < 3) {
                const int ti = w ? 1 : 0, si = (w == 2) ? 1 : 0;
                f32x16 a = (f32x16){};
#pragma unroll
                for (int ks = 0; ks < 8; ++ks) {
                    const s16x8 ka = *(const LAS s16x8*)(L + GLA_KT + (32 * si + l31) * PQ + (16 * ks + 8 * hi) * 2);
                    const s16x8 qb = *(const LAS s16x8*)(L + GLA_QT + (32 * ti + l31) * PQ + (16 * ks + 8 * hi) * 2);
                    a = __builtin_amdgcn_mfma_f32_32x32x16_bf16(ka, qb, a, 0, 0, 0);
                }
                const int t = 32 * ti + l31;
#pragma unroll
                for (int g4 = 0; g4 < 4; ++g4) { const int s0 = 32 * si + 8 * g4 + 4 * hi;
                    float v0 = a[4 * g4 + 0], v1 = a[4 * g4 + 1], v2 = a[4 * g4 + 2], v3 = a[4 * g4 + 3];
                    if (s0 + 0 > t) v0 = 0.f; if (s0 + 1 > t) v1 = 0.f; if (s0 + 2 > t) v2 = 0.f; if (s0 + 3 > t) v3 = 0.f;
                    *(LAS u32x2*)(L + GLA_AM + t * PA + s0 * 2) = (u32x2){pk2(v0, v1), pk2(v2, v3)}; }
            } else if (w == 3) {
                const int t = l31;
#pragma unroll
                for (int g4 = 0; g4 < 4; ++g4) *(LAS u32x2*)(L + GLA_AM + t * PA + (32 + 8 * g4 + 4 * hi) * 2) = (u32x2){0u, 0u};
            }
            __syncthreads();
            const int g1 = (lane >> 4) & 1, q = (lane & 15) >> 2, p = lane & 3;
            s16x8 vf[4];
#pragma unroll
            for (int ks = 0; ks < 4; ++ks) { const LAS unsigned char* vp = L + GLA_VS + (16 * ks + 8 * hi + q) * PV + (32 * w + 16 * g1 + 4 * p) * 2;
                vf[ks] = cat8(ldtr(vp), ldtr(vp + 4 * PV)); }
            if (!meta && variant != 2) {
#pragma unroll 1
                for (int ti = 0; ti < 2; ++ti) {
                    f32x16 o = (f32x16){};
                    const int t = 32 * ti + l31;
#pragma unroll
                    for (int ks = 0; ks < 4; ++ks) { const s16x8 af = *(const LAS s16x8*)(L + GLA_AM + t * PA + (16 * ks + 8 * hi) * 2);
                        o = __builtin_amdgcn_mfma_f32_32x32x16_bf16(af, vf[ks], o, 0, 0, 0); }
#pragma unroll
                    for (int dt = 0; dt < 4; ++dt) {
#pragma unroll
                        for (int s2 = 0; s2 < 2; ++s2) { const LAS unsigned char* qp = L + GLA_QT + t * PQ + (32 * dt + 16 * s2 + 4 * hi) * 2;
                            const s16x4v q0 = *(const LAS s16x4v*)qp, q1 = *(const LAS s16x4v*)(qp + 16);
                            v4u x; x.x = pk2(S[dt][8 * s2 + 0], S[dt][8 * s2 + 1]); x.y = pk2(S[dt][8 * s2 + 2], S[dt][8 * s2 + 3]); x.z = pk2(S[dt][8 * s2 + 4], S[dt][8 * s2 + 5]); x.w = pk2(S[dt][8 * s2 + 6], S[dt][8 * s2 + 7]);
                            o = __builtin_amdgcn_mfma_f32_32x32x16_bf16(cat8(q0, q1), __builtin_bit_cast(s16x8, x), o, 0, 0, 0); }
                        __builtin_amdgcn_sched_barrier(0);
                    }
                    { LAS unsigned char* op = L + GLA_VS + (32 * ti + 4 * hi) * PV + (32 * w + l31) * 2;
#pragma unroll
                      for (int r = 0; r < 16; ++r) *(LAS unsigned short*)(op + ((r & 3) + 8 * (r >> 2)) * PV) = (unsigned short)f2bf(o[r]); }
                }
            }
            __builtin_amdgcn_sched_barrier(0);
            if (variant != 2 && variant != 3) {
#pragma unroll
            for (int dt = 0; dt < 4; ++dt) {
#pragma unroll
                for (int ks = 0; ks < 4; ++ks) { const LAS unsigned char* kp = L + GLA_KT + (16 * ks + 8 * hi + q) * PQ + (32 * dt + 16 * g1 + 4 * p) * 2;
                    const s16x8 kf = cat8(ldtr(kp), ldtr(kp + 4 * PQ));
                    S[dt] = __builtin_amdgcn_mfma_f32_32x32x16_bf16(kf, vf[ks], S[dt], 0, 0, 0); }
#pragma unroll
                for (int r = 0; r < 16; ++r) S[dt][r] *= ((const LAS float*)(L + GLA_EBL))[32 * dt + crow16(r, hi)];
                __builtin_amdgcn_sched_barrier(0);
            }
            }
            __syncthreads();
            if (!meta && !dry) {
#pragma unroll
                for (int e = 0; e < 4; ++e) *(v4u*)(GV + (size_t)(row0 + srow) * 1024 + 256 * h + 32 * sseg + 8 * e) = *(const LAS v4u*)(L + GLA_VS + srow * PV + (32 * sseg + 8 * e) * 2);
            }
            __syncthreads();
        }
        float* Lu = LBUF + (size_t)u * 32768 + (4 * hi) * 256 + 32 * w + l31;
#pragma unroll
        for (int dt = 0; dt < 4; ++dt) { asm volatile("" : "+v"(Lu));
#pragma unroll
            for (int r = 0; r < 16; ++r) { if (!dry) Lu[((r & 3) + 8 * (r >> 2)) * 256] = S[dt][r]; else asm volatile("" :: "v"(S[dt][r])); }
            Lu += 32 * 256; }
        if (w == 0 && !dry) *(f32x2*)(DBUF + u * 128 + d0) = (f32x2){__expf(Bs0), __expf(Bs1)};
    }
}

__device__ __forceinline__ void gla_phase_b(Frame& F) {
    unsigned char* ws = F.ws;
    const float* LBUF = (const float*)(ws + WS_LBUF); const float* DBUF = (const float*)(ws + WS_DBUF); bf16* TT = (bf16*)(ws + WS_TT);
    const int gt = F.vcu * (NWAVES * 64) + fresh_tid(), NT = F.G * NWAVES * 64;
    for (int e = gt; e < 8 * 32768; e += NT) {
        const int bh = e >> 15, idx = e & 32767, dd = idx >> 8, h = bh & 3;
        float T = LBUF[(size_t)(GLA_NU + h) * 32768 + idx];
        float Lv[8], Dv[8];
        for (int j0 = 0; j0 < GLA_NSC; j0 += 8) {
#pragma unroll
            for (int jj = 0; jj < 8; ++jj) { const int u = bh * GLA_NSC + j0 + jj; Lv[jj] = LBUF[(size_t)u * 32768 + idx]; Dv[jj] = DBUF[u * 128 + dd]; }
#pragma unroll
            for (int jj = 0; jj < 8; ++jj) { const int u = bh * GLA_NSC + j0 + jj; TT[(size_t)u * 32768 + idx] = (bf16)f2bf(T); T = Dv[jj] * T + Lv[jj]; }
        }
    }
}

constexpr int GLC_TS = 0, GLC_OS = 67584, PO = 1056;
__device__ __forceinline__ void gla_phase_c(Frame& F, bool dry) {
    unsigned char* ws = F.ws;
    const bf16* GQ = (const bf16*)(ws + WS_GQ); const bf16* GV = (const bf16*)(ws + WS_GV); bf16* GR = (bf16*)(ws + WS_GR); const bf16* TT = (const bf16*)(ws + WS_TT);
    LAS unsigned char* L = F.lds + RING_OFF;
    const int tid = fresh_tid(), lane = tid & 63, w = __builtin_amdgcn_readfirstlane(tid >> 6), hi = lane >> 5, l31 = lane & 31;
    const int g1 = (lane >> 4) & 1, q = (lane & 15) >> 2, p = lane & 3;
    for (int u = F.vcu; u < GLA_NU; u += F.G) {
        const int b = u >> 7, h = (u >> 5) & 3, j = u & 31;
        __syncthreads();
        { const int tr = tid >> 2, seg = tid & 3;
#pragma unroll
          for (int q8 = 0; q8 < 8; ++q8) *(LAS v4u*)(L + GLC_TS + tr * PV + (64 * seg + 8 * q8) * 2) = *(const v4u*)(TT + (size_t)u * 32768 + tr * 256 + 64 * seg + 8 * q8); }
        __syncthreads();
        s16x8 tf[8];
#pragma unroll
        for (int ks = 0; ks < 8; ++ks) { const LAS unsigned char* tp = L + GLC_TS + (16 * ks + 8 * hi + q) * PV + (32 * w + 16 * g1 + 4 * p) * 2; tf[ks] = cat8(ldtr(tp), ldtr(tp + 4 * PV)); }
        const f32x4 gn4 = *(const f32x4*)(F.gn + 4 * lane);
#pragma unroll 1
        for (int ct = 0; ct < 2 * GLA_NCH; ++ct) {
            const int row0 = b * TSEQ + 256 * j + 32 * ct;
            u32x2 ol[4], rv[4];
#pragma unroll
            for (int rr = 0; rr < 4; ++rr) { const int row = row0 + 4 * w + rr; ol[rr] = *(const u32x2*)(GV + (size_t)row * 1024 + 256 * h + 4 * lane); rv[rr] = *(const u32x2*)(GR + (size_t)row * 1024 + 256 * h + 4 * lane); }
            f32x16 o = (f32x16){};
            const bf16* qrow = GQ + (size_t)(row0 + l31) * 512 + 128 * h + 8 * hi;
            s16x8 af[8];
#pragma unroll
            for (int ks = 0; ks < 8; ++ks) af[ks] = *(const s16x8*)(qrow + 16 * ks);
#pragma unroll
            for (int ks = 0; ks < 8; ++ks) o = __builtin_amdgcn_mfma_f32_32x32x16_bf16(af[ks], tf[ks], o, 0, 0, 0);
#pragma unroll
            for (int r = 0; r < 16; ++r) *(LAS float*)(L + GLC_OS + crow16(r, hi) * PO + (32 * w + l31) * 4) = o[r];
            __syncthreads();
#pragma unroll
            for (int rr = 0; rr < 4; ++rr) { const int lr = 4 * w + rr, row = row0 + lr;
                const f32x4 ov = *(const LAS f32x4*)(L + GLC_OS + lr * PO + lane * 16);
                f32x4 t4; t4[0] = ov[0] + bf2f((unsigned short)(ol[rr].x & 0xffff)); t4[1] = ov[1] + bf2f((unsigned short)(ol[rr].x >> 16)); t4[2] = ov[2] + bf2f((unsigned short)(ol[rr].y & 0xffff)); t4[3] = ov[3] + bf2f((unsigned short)(ol[rr].y >> 16));
                const float ss = wave_sum((t4[0] * t4[0] + t4[1] * t4[1]) + (t4[2] * t4[2] + t4[3] * t4[3]));
                const float rs = 1.f / sqrtf(ss * (1.f / 256.f) + 1e-6f);
                f32x4 y; y[0] = t4[0] * rs * gn4[0] * bf2f((unsigned short)(rv[rr].x & 0xffff)); y[1] = t4[1] * rs * gn4[1] * bf2f((unsigned short)(rv[rr].x >> 16));
                y[2] = t4[2] * rs * gn4[2] * bf2f((unsigned short)(rv[rr].y & 0xffff)); y[3] = t4[3] * rs * gn4[3] * bf2f((unsigned short)(rv[rr].y >> 16));
                if (!dry) *(u32x2*)(GR + (size_t)row * 1024 + 256 * h + 4 * lane) = (u32x2){pk2(y[0], y[1]), pk2(y[2], y[3])}; else asm volatile("" :: "v"(y[0]), "v"(y[1]), "v"(y[2]), "v"(y[3])); }
            __syncthreads();
        }
    }
}


namespace ix {
constexpr int IQP = 1296;
constexpr int OFF_IQ = 0, OFF_H = 41472, HPW = 356  , OFF_M = OFF_H + 32 * HPW * 4, OFF_RI = OFF_M + 32 * MASKW * 4, OFF_CC = OFF_RI + 384;
constexpr int NB = 708, CAP = 128;
static_assert(32 * CAP * 8 <= 32 * HPW * 4 && OFF_CC + 128 <= RING_BYTES, "indexer LDS map");
__device__ __forceinline__ int score_bin(float s) {
    const unsigned b = __float_as_uint(s);
    int mag = (int)((b & 0x7fffffffu) >> 18) - (120 * 32 - 1);
    mag = mag < 0 ? 0 : (mag > 353 ? 353 : mag);
    return 354 + (mag ^ ((int)b >> 31));
}
__device__ __forceinline__ void load_kf(s16x8 (&kf)[4], const bf16* IKb, int kt, int r32, int hi) {
    const bf16* kp = IKb + (size_t)(32 * kt + r32) * 64 + 8 * hi;
#pragma unroll
    for (int d0 = 0; d0 < 4; ++d0) kf[d0] = *(const s16x8*)(kp + 16 * d0);
}
__device__ __forceinline__ void tile_scores(f32x16& sc, const s16x8 (&kf)[4], LAS unsigned char* L, int r32, int hi, const float (&cw)[8]) {
    sc = (f32x16){};
#pragma unroll
    for (int h = 8; h < 10; ++h)
#pragma unroll
        for (int d0 = 0; d0 < 4; ++d0) { const s16x8 qf = *(const LAS s16x8*)(L + OFF_IQ + r32 * IQP + (h * 64 + 16 * d0 + 8 * hi) * 2);
            sc = __builtin_amdgcn_mfma_f32_32x32x16_bf16(kf[d0], qf, sc, 0, 0, 0); }
#define IX_HEAD(A, H) do { A = (f32x16){}; _Pragma("unroll") for (int d0 = 0; d0 < 4; ++d0) { const s16x8 qf = *(const LAS s16x8*)(L + OFF_IQ + r32 * IQP + ((H) * 64 + 16 * d0 + 8 * hi) * 2); \
        A = __builtin_amdgcn_mfma_f32_32x32x16_bf16(kf[d0], qf, A, 0, 0, 0); } } while (0)
#define IX_ACC(A, H) do { _Pragma("unroll") for (int r = 0; r < 16; ++r) sc[r] = __builtin_fmaf(__builtin_fabsf(A[r]), cw[H], sc[r]); } while (0)
    f32x16 aA, aB;
    IX_HEAD(aA, 0);
#pragma unroll
    for (int h = 0; h < 8; h += 2) {
        IX_HEAD(aB, h + 1); __builtin_amdgcn_sched_barrier(0);
        IX_ACC(aA, h); __builtin_amdgcn_sched_barrier(0);
        if (h + 2 < 8) { IX_HEAD(aA, h + 2); } __builtin_amdgcn_sched_barrier(0);
        IX_ACC(aB, h + 1); __builtin_amdgcn_sched_barrier(0);
    }
#undef IX_HEAD
#undef IX_ACC
#pragma unroll
    for (int r = 0; r < 16; ++r) sc[r] += 0.0f;
}
__device__ __forceinline__ float bin_lo(int b) { const int mag = b - 354; return __uint_as_float((unsigned)(mag + 120 * 32 - 1) << 18); }
}

__device__ __forceinline__ void idx_phase(Frame& F, int variant = 0) {
    using namespace ix;
    unsigned char* ws = F.ws;
    const bf16* IQ = (const bf16*)(ws + WS_IQ); const bf16* IKB = (const bf16*)(ws + WS_IKB); const float* IW = (const float*)(ws + WS_IW); unsigned* MASK = (unsigned*)(ws + WS_MASK);
    LAS unsigned char* L = F.lds + RING_OFF;
    const int tid = fresh_tid(), lane = tid & 63, w = __builtin_amdgcn_readfirstlane(tid >> 6), hi = lane >> 5, r32 = lane & 31;
    { const int v = F.vcu & 255;
        const int b = v >> 7, m = v & 127;
#pragma unroll 1
        for (int ui = 0; ui < 2; ++ui) {
            const int qb = ui ? 255 - m : m;
            const int row0 = b * TSEQ + 32 * qb;
            const int qpos = NMETA + 32 * qb + r32;
            const int nkt = qb + 2;
            const bf16* IKb = IKB + (size_t)b * KVR * 64;
            __syncthreads();
            { const int rr = tid >> 4, seg = tid & 15;
#pragma unroll
              for (int q4 = 0; q4 < 4; ++q4) *(LAS v4u*)(L + OFF_IQ + rr * IQP + (32 * seg + 8 * q4) * 2) = *(const v4u*)(IQ + (size_t)(row0 + rr) * 512 + 32 * seg + 8 * q4); }
            for (int i = tid; i < 32 * HPW + 32 * MASKW + 128; i += 512) ((LAS unsigned*)(L + OFF_H))[i] = 0u;
            float cw[8];
            { const f32x4 a = *(const f32x4*)(IW + (size_t)(row0 + r32) * 8), c = *(const f32x4*)(IW + (size_t)(row0 + r32) * 8 + 4);
              cw[0] = 0.5f * a[0]; cw[1] = 0.5f * a[1]; cw[2] = 0.5f * a[2]; cw[3] = 0.5f * a[3]; cw[4] = 0.5f * c[0]; cw[5] = 0.5f * c[1]; cw[6] = 0.5f * c[2]; cw[7] = 0.5f * c[3]; }
            __syncthreads();
            { const int rr = tid >> 4, seg = tid & 15;
              const f32x4 a = *(const f32x4*)(IW + (size_t)(row0 + rr) * 8), c = *(const f32x4*)(IW + (size_t)(row0 + rr) * 8 + 4);
              const float wv[8] = {0.5f * a[0], 0.5f * a[1], 0.5f * a[2], 0.5f * a[3], 0.5f * c[0], 0.5f * c[1], 0.5f * c[2], 0.5f * c[3]};
              float qs[4] = {0.f, 0.f, 0.f, 0.f};
#pragma unroll
              for (int h = 0; h < 8; ++h) { const u32x2 x = *(const LAS u32x2*)(L + OFF_IQ + rr * IQP + (h * 64 + 4 * seg) * 2);
                  qs[0] += wv[h] * bf2f((unsigned short)(x.x & 0xffff)); qs[1] += wv[h] * bf2f((unsigned short)(x.x >> 16)); qs[2] += wv[h] * bf2f((unsigned short)(x.y & 0xffff)); qs[3] += wv[h] * bf2f((unsigned short)(x.y >> 16)); }
              unsigned hb[4], lb[4];
#pragma unroll
              for (int e = 0; e < 4; ++e) { hb[e] = f2bf(qs[e]); lb[e] = f2bf(qs[e] - bf2f((unsigned short)hb[e])); }
              *(LAS u32x2*)(L + OFF_IQ + rr * IQP + (8 * 64 + 4 * seg) * 2) = (u32x2){hb[0] | (hb[1] << 16), hb[2] | (hb[3] << 16)};
              *(LAS u32x2*)(L + OFF_IQ + rr * IQP + (9 * 64 + 4 * seg) * 2) = (u32x2){lb[0] | (lb[1] << 16), lb[2] | (lb[3] << 16)}; }
            __syncthreads();
#define IX_P1(KF, KT) do { f32x16 sc; tile_scores(sc, KF, L, r32, hi, cw); \
                if (variant == 2) { _Pragma("unroll") for (int r = 0; r < 16; ++r) asm volatile("" :: "v"(sc[r])); break; } \
                if ((KT) < qb) { _Pragma("unroll") for (int r = 0; r < 16; ++r) { const int bin = score_bin(sc[r]); \
                        __hip_atomic_fetch_add((LAS unsigned*)(L + OFF_H) + r32 * HPW + (bin >> 1), 1u << (16 * (bin & 1)), __ATOMIC_RELAXED, __HIP_MEMORY_SCOPE_WORKGROUP); } } \
                else { _Pragma("unroll") for (int r = 0; r < 16; ++r) { const int key = 32 * (KT) + crow16(r, hi); const int bin = score_bin(sc[r]); \
                        if (key <= qpos) __hip_atomic_fetch_add((LAS unsigned*)(L + OFF_H) + r32 * HPW + (bin >> 1), 1u << (16 * (bin & 1)), __ATOMIC_RELAXED, __HIP_MEMORY_SCOPE_WORKGROUP); } } } while (0)
            if (variant != 1) { s16x8 kfA[4], kfB[4]; int kt = w;
              if (kt < nkt) load_kf(kfA, IKb, kt, r32, hi);
#pragma unroll 1
              for (; kt < nkt; kt += 8) {
                  load_kf(kfB, IKb, (kt + 8 < nkt) ? kt + 8 : kt, r32, hi);
                  IX_P1(kfA, kt);
#pragma unroll
                  for (int d0 = 0; d0 < 4; ++d0) kfA[d0] = kfB[d0];
              } }
#undef IX_P1
            __syncthreads();
#pragma unroll 1
            for (int rr = 0; rr < 4; ++rr) {
                const int row = 4 * w + rr, n = NMETA + 32 * qb + row + 1;
                LAS int* ri = (LAS int*)(L + OFF_RI) + row * 3;
                if (n <= 256) { if (lane == 0) { ri[0] = -1; ri[1] = 0; ri[2] = 0; } continue; }
                const LAS unsigned short* hs = (const LAS unsigned short*)(L + OFF_H + row * HPW * 4);
                const int hib = NB - 1 - 12 * lane;
                int s = 0;
#pragma unroll
                for (int k = 0; k < 12; ++k) { const int bin = hib - k; if (bin >= 0) s += hs[bin]; }
                int P = s;
#pragma unroll
                for (int o = 1; o < 64; o <<= 1) { const int t = __shfl_up(P, o); if (lane >= o) P += t; }
                const unsigned long long bal = __ballot(P >= 256);
                const int first = bal ? __builtin_ctzll(bal) : 63;
                if (lane == first) { int chi = P - s; int bs = -1, need = 0, cb = 0;
                    for (int k = 0; k < 12; ++k) { const int bin = hib - k; if (bin < 0) break; const int c = hs[bin];
                        if (chi + c >= 256) { bs = bin; need = 256 - chi; cb = c; break; } chi += c; }
                    ri[0] = bs; ri[1] = need; ri[2] = cb; }
            }
            __syncthreads();
            const int bstar = ((const LAS int*)(L + OFF_RI))[r32 * 3];
            const bool fastp = __all(bstar >= 355 && bstar <= 705);
            const float lob = bin_lo(bstar), hib_f = bin_lo(bstar + 1);
#define IX_APPEND(SC, KEY) do { const unsigned slot = __hip_atomic_fetch_add((LAS unsigned*)(L + OFF_CC) + r32, 1u, __ATOMIC_RELAXED, __HIP_MEMORY_SCOPE_WORKGROUP); \
                if (slot < (unsigned)CAP) { LAS unsigned* cd = (LAS unsigned*)(L + OFF_H) + (r32 * CAP + slot) * 2; cd[0] = __float_as_uint(SC); cd[1] = (unsigned)(KEY); } } while (0)
#define IX_P2(KF, KT) do { f32x16 sc; tile_scores(sc, KF, L, r32, hi, cw); unsigned bits = 0u; \
                if (variant == 2) { _Pragma("unroll") for (int r = 0; r < 16; ++r) asm volatile("" :: "v"(sc[r])); break; } \
                if (fastp && (KT) < qb) { _Pragma("unroll") for (int r = 0; r < 16; ++r) { \
                        if (sc[r] >= hib_f) bits |= 1u << crow16(r, hi); else if (sc[r] >= lob) IX_APPEND(sc[r], 32 * (KT) + crow16(r, hi)); } } \
                else { _Pragma("unroll") for (int r = 0; r < 16; ++r) { const int key = 32 * (KT) + crow16(r, hi); \
                        if (key <= qpos) { const int bin = score_bin(sc[r]); if (bin > bstar) bits |= 1u << crow16(r, hi); else if (bin == bstar) IX_APPEND(sc[r], key); } } } \
                if (bits) __hip_atomic_fetch_or((LAS unsigned*)(L + OFF_M) + r32 * MASKW + (KT), bits, __ATOMIC_RELAXED, __HIP_MEMORY_SCOPE_WORKGROUP); } while (0)
            if (variant != 1 && variant != 3) { s16x8 kfA[4], kfB[4]; int kt = w;
              if (kt < nkt) load_kf(kfA, IKb, kt, r32, hi);
#pragma unroll 1
              for (; kt < nkt; kt += 8) {
                  load_kf(kfB, IKb, (kt + 8 < nkt) ? kt + 8 : kt, r32, hi);
                  IX_P2(kfA, kt);
#pragma unroll
                  for (int d0 = 0; d0 < 4; ++d0) kfA[d0] = kfB[d0];
              } }
#undef IX_P2
#undef IX_APPEND
            __syncthreads();
#pragma unroll 1
            for (int rr = 0; rr < 4; ++rr) {
                const int row = 4 * w + rr;
                const int need = ((const LAS int*)(L + OFF_RI))[row * 3 + 1];
                int cnt = (int)((const LAS unsigned*)(L + OFF_CC))[row]; cnt = cnt > CAP ? CAP : cnt;
                const LAS unsigned* cd = (const LAS unsigned*)(L + OFF_H) + row * CAP * 2;
                for (int c = lane; c < cnt; c += 64) {
                    const float sc_ = __uint_as_float(cd[2 * c]); const unsigned ic = cd[2 * c + 1];
                    int rank = 0;
                    for (int c2 = 0; c2 < cnt; ++c2) { const float s2 = __uint_as_float(cd[2 * c2]); const unsigned i2 = cd[2 * c2 + 1]; rank += (s2 > sc_ || (s2 == sc_ && i2 < ic)) ? 1 : 0; }
                    if (rank < need) __hip_atomic_fetch_or((LAS unsigned*)(L + OFF_M) + row * MASKW + (ic >> 5), 1u << (ic & 31), __ATOMIC_RELAXED, __HIP_MEMORY_SCOPE_WORKGROUP);
                }
            }
            __syncthreads();
            const int nw = 2 * (4 * (qb >> 3) + 6);
            for (int i = tid; i < 32 * MASKW; i += 512) { const int row = i / MASKW, wd = i - row * MASKW;
                if (wd < nw) MASK[(size_t)(row0 + row) * MASKW + wd] = ((const LAS unsigned*)(L + OFF_M))[i]; }
        }
    }
}


namespace at {
constexpr int D = 128, NW = 8, QBLK = 32, KVBLK = 64, LDX = 1024;
constexpr float THR = 8.f;
constexpr size_t SHM_V = KVBLK * D * 2, SHM_K = KVBLK * D * 2;
constexpr int OFF_WS = 2 * SHM_V + 2 * SHM_K, OFF_BT = OFF_WS + NW * 64 * 4;
#define KSWZ(row, colB) ((row) * 256 + ((colB) ^ (((row) & 7) << 4)))
#define SBAR() __builtin_amdgcn_sched_barrier(0)
__device__ __forceinline__ unsigned cvtpk(float lo, float hi) { unsigned r; asm volatile("v_cvt_pk_bf16_f32 %0, %1, %2" : "=v"(r) : "v"(lo), "v"(hi)); return r; }
__device__ __forceinline__ void partialSM(f32x16& p0, f32x16& p1, float& m_reg, float& mn, float& alpha) {
  float pmax = p0[0];
#pragma unroll
  for (int r = 1; r < 16; ++r) pmax = fmaxf(pmax, p0[r]);
#pragma unroll
  for (int r = 0; r < 16; ++r) pmax = fmaxf(pmax, p1[r]);
  { auto rr = __builtin_amdgcn_permlane32_swap(__float_as_uint(pmax), __float_as_uint(pmax), false, false);
    pmax = fmaxf(__uint_as_float(rr[0]), __uint_as_float(rr[1])); }
  if (__builtin_expect(__all(pmax - m_reg <= THR), 1)) { mn = m_reg; alpha = 1.f; }
  else { mn = fmaxf(m_reg, pmax); alpha = __builtin_amdgcn_exp2f(m_reg - mn); m_reg = mn; }
#pragma unroll
  for (int r = 0; r < 16; ++r) p0[r] = p0[r] - mn;
#pragma unroll
  for (int r = 0; r < 16; ++r) p1[r] = p1[r] - mn;
#pragma unroll
  for (int r = 0; r < 16; ++r) p0[r] = __builtin_amdgcn_exp2f(p0[r]);
}
__device__ __forceinline__ void finishSM(f32x16& p0, f32x16& p1, float alpha, float& l_reg, s16x8& pa0, s16x8& pa1, s16x8& pa2, s16x8& pa3) {
#pragma unroll
  for (int r = 0; r < 16; ++r) p1[r] = __builtin_amdgcn_exp2f(p1[r]);
  float ps = 0;
#pragma unroll
  for (int r = 0; r < 16; ++r) ps += p0[r];
#pragma unroll
  for (int r = 0; r < 16; ++r) ps += p1[r];
  { auto rr = __builtin_amdgcn_permlane32_swap(__float_as_uint(ps), __float_as_uint(ps), false, false);
    ps = __uint_as_float(rr[0]) + __uint_as_float(rr[1]); }
  l_reg = l_reg * alpha + ps;
#define PK4(P, BASE, OUT) do { unsigned a0 = cvtpk(P[BASE + 0], P[BASE + 1]), a1 = cvtpk(P[BASE + 2], P[BASE + 3]);   \
    unsigned b0 = cvtpk(P[BASE + 4], P[BASE + 5]), b1 = cvtpk(P[BASE + 6], P[BASE + 7]);                              \
    auto r0 = __builtin_amdgcn_permlane32_swap(a0, b0, false, false); auto r1 = __builtin_amdgcn_permlane32_swap(a1, b1, false, false); \
    v4u w_ = {r0[0], r1[0], r0[1], r1[1]}; OUT = __builtin_bit_cast(s16x8, w_); } while (0)
  PK4(p0, 0, pa0); PK4(p0, 8, pa1); PK4(p1, 0, pa2); PK4(p1, 8, pa3);
#undef PK4
}
__device__ __forceinline__ void qkt(f32x16& p0, f32x16& p1, const unsigned char* Ks, const s16x8* qr, int r32, int hi) {
#pragma unroll
  for (int d0 = 0; d0 < 8; ++d0) { const int cb = (d0 * 16 + hi * 8) * 2;
    const s16x8 b0 = *reinterpret_cast<const s16x8*>(Ks + KSWZ(r32, cb));
    const s16x8 b1 = *reinterpret_cast<const s16x8*>(Ks + KSWZ(32 + r32, cb));
    p0 = __builtin_amdgcn_mfma_f32_32x32x16_bf16(b0, qr[d0], p0, 0, 0, 0);
    p1 = __builtin_amdgcn_mfma_f32_32x32x16_bf16(b1, qr[d0], p1, 0, 0, 0); }
}
__device__ __forceinline__ int v_st(int k, int c) { const int kk = (k & ~0xC) | ((k & 4) << 1) | ((k & 8) >> 1); return ((kk >> 3) * 4 + (c >> 5)) * 512 + ((kk & 7) * 32 + (c & 31)) * 2; }
__device__ __forceinline__ int v_rd_base(int lane) { return ((lane & 3) << 3) | (((lane >> 2) & 3) << 6) | (((lane >> 4) & 1) << 5) | (((lane >> 5) & 1) << 8); }
constexpr int v_rd_off(int d0, int ks, int half) { return d0 * 512 + ks * 4096 + half * 2048; }
template <int OFF> __device__ __forceinline__ s16x4v tr_read(int vb) {
  s16x4v r; asm volatile("ds_read_b64_tr_b16 %0, %1 offset:%2" : "=&v"(r) : "v"(vb), "i"(OFF) : "memory"); return r;
}
template <int D0> __device__ __forceinline__ void pv_one(f32x16& od, int vb, s16x8 pa0, s16x8 pa1, s16x8 pa2, s16x8 pa3) {
  const s16x4v l0 = tr_read<v_rd_off(D0, 0, 0)>(vb), h0 = tr_read<v_rd_off(D0, 0, 1)>(vb), l1 = tr_read<v_rd_off(D0, 1, 0)>(vb), h1 = tr_read<v_rd_off(D0, 1, 1)>(vb);
  const s16x4v l2 = tr_read<v_rd_off(D0, 2, 0)>(vb), h2 = tr_read<v_rd_off(D0, 2, 1)>(vb), l3 = tr_read<v_rd_off(D0, 3, 0)>(vb), h3 = tr_read<v_rd_off(D0, 3, 1)>(vb);
  asm volatile("s_waitcnt lgkmcnt(0)" ::: "memory"); SBAR();
#define PK(L, H) (s16x8){L[0], L[1], L[2], L[3], H[0], H[1], H[2], H[3]}
  od = __builtin_amdgcn_mfma_f32_32x32x16_bf16(pa0, PK(l0, h0), od, 0, 0, 0);
  od = __builtin_amdgcn_mfma_f32_32x32x16_bf16(pa1, PK(l1, h1), od, 0, 0, 0);
  od = __builtin_amdgcn_mfma_f32_32x32x16_bf16(pa2, PK(l2, h2), od, 0, 0, 0);
  od = __builtin_amdgcn_mfma_f32_32x32x16_bf16(pa3, PK(l3, h3), od, 0, 0, 0);
#undef PK
}
__device__ __forceinline__ void pv_d0(f32x16* o, int vb, s16x8 pa0, s16x8 pa1, s16x8 pa2, s16x8 pa3) {
  pv_one<0>(o[0], vb, pa0, pa1, pa2, pa3); pv_one<1>(o[1], vb, pa0, pa1, pa2, pa3); pv_one<2>(o[2], vb, pa0, pa1, pa2, pa3); pv_one<3>(o[3], vb, pa0, pa1, pa2, pa3);
}
__device__ __forceinline__ void mk_init(f32x16& p0, f32x16& p1, u32x2 mw, int t, int qpos, int hi, bool near, const float* bt) {
  const unsigned w0 = mw.x >> (4 * hi), w1 = mw.y >> (4 * hi);
  const float NEG = -INFINITY;
  if (near) {
    const int db = qpos - (64 * t + 4 * hi);
#pragma unroll
    for (int r = 0; r < 16; ++r) { const int c = (r & 3) + 8 * (r >> 2);
      int d0 = db - c, d1 = db - 32 - c; d0 = d0 < 0 ? 0 : (d0 > 127 ? 127 : d0); d1 = d1 < 0 ? 0 : (d1 > 127 ? 127 : d1);
      p0[r] = ((w0 >> c) & 1u) ? bt[d0] : NEG; p1[r] = ((w1 >> c) & 1u) ? bt[d1] : NEG; }
  } else {
#pragma unroll
    for (int r = 0; r < 16; ++r) { const int c = (r & 3) + 8 * (r >> 2);
      p0[r] = ((w0 >> c) & 1u) ? 0.f : NEG; p1[r] = ((w1 >> c) & 1u) ? 0.f : NEG; }
  }
}

__device__ __forceinline__ void attn_unit(const bf16* __restrict__ Qb, const bf16* __restrict__ Kh, const bf16* __restrict__ Vh, bf16* Ob, const unsigned* __restrict__ Mb, int qpos0, int NT, const float* btg, unsigned char* lds, bool dry) {
  int tid_ = threadIdx.x; asm volatile("" : "+v"(tid_));
  const int tid = tid_, wid = __builtin_amdgcn_readfirstlane(tid >> 6), lane = tid & 63, r32 = lane & 31, hi = lane >> 5;
  unsigned char* V_lds = lds; unsigned char* K_lds = lds + 2 * SHM_V;
  float* ws = (float*)(lds + OFF_WS) + wid * 64; float* li_l = ws; float* al_l = ws + 32;
  float* bt = (float*)(lds + OFF_BT);
  if (tid < 128) bt[tid] = btg[tid];
  float m_reg = -1e30f, l_reg = 0; f32x16 o[4] = {}; s16x8 qr[8];
  const bf16* Qw = Qb + (long)(wid * QBLK + r32) * LDX + hi * 8;
#pragma unroll
  for (int d0 = 0; d0 < 8; ++d0) qr[d0] = *reinterpret_cast<const s16x8*>(Qw + d0 * 16);
  const int sr = tid >> 4, sc = (tid & 15) * 8, vst0 = v_st(sr, sc), kst0 = KSWZ(sr, sc * 2);
  const int vb0 = (int)(uintptr_t)V_lds + v_rd_base(lane);
  struct { s16x8 vs0, vs1, ks0, ks1; } sr_[1];
  const int qpos = qpos0 + wid * QBLK + r32, qmin = qpos0 + wid * QBLK;
  const unsigned moff = (unsigned)((wid * QBLK + r32) * MASKW * 4);
  const unsigned voff0 = (unsigned)((sr * LDX + sc) * 2);
#define SLOAD(i, k0) do { const char* vt_ = (const char*)Vh + (size_t)(k0) * (LDX * 2); const char* kt_ = (const char*)Kh + (size_t)(k0) * (LDX * 2); \
    sr_[i].vs0 = *(const s16x8*)(vt_ + voff0); sr_[i].vs1 = *(const s16x8*)((vt_ + 32 * LDX * 2) + voff0); \
    sr_[i].ks0 = *(const s16x8*)(kt_ + voff0); sr_[i].ks1 = *(const s16x8*)((kt_ + 32 * LDX * 2) + voff0); } while (0)
#define SWRITE(b, i) do { *(s16x8*)(V_lds + (b) * SHM_V + vst0) = sr_[i].vs0;          \
    *(s16x8*)(V_lds + (b) * SHM_V + 8192 + vst0) = sr_[i].vs1;               \
    *(s16x8*)(K_lds + (b) * SHM_K + kst0) = sr_[i].ks0;                       \
    *(s16x8*)(K_lds + (b) * SHM_K + 8192 + kst0) = sr_[i].ks1; } while (0)
#define SWAIT() asm volatile("s_waitcnt vmcnt(0)" ::: "memory")
#define RESC(a) do { if (__any((a) < 1.f)) { if (hi == 0) al_l[r32] = (a); asm volatile("s_waitcnt lgkmcnt(0)" ::: "memory"); \
    _Pragma("unroll") for (int d = 0; d < 4; ++d) _Pragma("unroll") for (int r = 0; r < 16; ++r) o[d][r] *= al_l[crow16(r, hi)]; } } while (0)
#define MLOAD(t) (*(const u32x2*)((const char*)Mb + (size_t)(8 * (t)) + moff))
#define NEAR(t) (64 * (t) + 63 + 113 > qmin)
  f32x16 pA0, pA1, pB0, pB1; float mnA, mnB, alA, alB; s16x8 pa0, pa1, pa2, pa3;
  constexpr int SE = 0, SO = 0;
  SLOAD(SE, 0); asm volatile("s_waitcnt vmcnt(0)" ::: "memory"); SWRITE(0, SE); __syncthreads();
  mk_init(pA0, pA1, MLOAD(0), 0, qpos, hi, NEAR(0), bt);
  qkt(pA0, pA1, K_lds, qr, r32, hi); partialSM(pA0, pA1, m_reg, mnA, alA);
  SLOAD(SO, KVBLK);
  SWAIT(); SWRITE(1, SO); __syncthreads();
  for (int j = 1; j + 1 < NT; j += 2) {
    mk_init(pB0, pB1, MLOAD(j), j, qpos, hi, NEAR(j), bt);
    SBAR(); qkt(pB0, pB1, K_lds + SHM_K, qr, r32, hi);
    finishSM(pA0, pA1, alA, l_reg, pa0, pa1, pa2, pa3); SBAR();
    SLOAD(SO, (j + 1) * KVBLK); SBAR();
    pv_d0(o, vb0, pa0, pa1, pa2, pa3); partialSM(pB0, pB1, m_reg, mnB, alB);
    __syncthreads(); SWAIT(); SWRITE(0, SE);
    RESC(alB); __syncthreads();
    mk_init(pA0, pA1, MLOAD(j + 1), j + 1, qpos, hi, NEAR(j + 1), bt);
    SBAR(); qkt(pA0, pA1, K_lds, qr, r32, hi);
    finishSM(pB0, pB1, alB, l_reg, pa0, pa1, pa2, pa3); SBAR();
    SLOAD(SE, (j + 2) * KVBLK); SBAR();
    pv_d0(o, vb0 + (int)SHM_V, pa0, pa1, pa2, pa3); partialSM(pA0, pA1, m_reg, mnA, alA);
    __syncthreads(); SWAIT(); SWRITE(1, SO);
    RESC(alA); __syncthreads();
  }
  mk_init(pB0, pB1, MLOAD(NT - 1), NT - 1, qpos, hi, NEAR(NT - 1), bt);
  SBAR(); qkt(pB0, pB1, K_lds + SHM_K, qr, r32, hi);
  finishSM(pA0, pA1, alA, l_reg, pa0, pa1, pa2, pa3); SBAR();
  pv_d0(o, vb0, pa0, pa1, pa2, pa3); partialSM(pB0, pB1, m_reg, mnB, alB);
  __syncthreads(); RESC(alB);
  finishSM(pB0, pB1, alB, l_reg, pa0, pa1, pa2, pa3); SBAR();
  pv_d0(o, vb0 + (int)SHM_V, pa0, pa1, pa2, pa3);
  if (hi == 0) li_l[r32] = l_reg; asm volatile("s_waitcnt lgkmcnt(0)" ::: "memory");
  float rli[16];
#pragma unroll
  for (int r = 0; r < 16; ++r) rli[r] = __builtin_amdgcn_rcpf(li_l[crow16(r, hi)]);
  bf16* Ow = Ob + (long)(wid * QBLK + 4 * hi) * LDX + r32; asm volatile("" : "+v"(Ow));
#pragma unroll
  for (int r = 0; r < 16; ++r) {
#pragma unroll
    for (int d0 = 0; d0 < 4; ++d0) { if (!dry) Ow[(long)((r & 3) + 8 * (r >> 2)) * LDX + d0 * 32] = (bf16)f2bf(o[d0][r] * rli[r]); else asm volatile("" :: "v"(o[d0][r] * rli[r])); } }
  __syncthreads();
#undef SLOAD
#undef SWRITE
#undef SWAIT
#undef RESC
#undef MLOAD
#undef NEAR
}
#undef KSWZ
#undef SBAR
}

__device__ __forceinline__ void attn_phase(Frame& F, bool dry) {
    unsigned char* ws = F.ws;
    bf16* DQ = (bf16*)(ws + WS_DQ); const bf16* DK = (const bf16*)(ws + WS_DKB); const bf16* DV = (const bf16*)(ws + WS_DVB);
    const unsigned* MASK = (const unsigned*)(ws + WS_MASK); const float* BT = (const float*)(ws + WS_BIAST);
    { const int v = F.vcu & 255;
        const int bh = v >> 4, s = v & 15, b = bh >> 3, h = bh & 7;
#pragma unroll 1
        for (int i = 0; i < 2; ++i) {
            const int jq = i ? 31 - s : s;
            const size_t qrow = (size_t)b * TSEQ + 256 * jq;
            at::attn_unit(DQ + qrow * 1024 + 128 * h, DK + (size_t)b * KVR * 1024 + 128 * h, DV + (size_t)b * KVR * 1024 + 128 * h, DQ + qrow * 1024 + 128 * h,
                          MASK + qrow * MASKW, NMETA + 256 * jq, 4 * jq + 6, BT + 128 * h, (unsigned char*)(F.lds + RING_OFF), dry);
        }
    }
}


#ifndef MK_N_LAUNCHES
#define MK_N_LAUNCHES 1
#endif
#ifndef PROBE_DUP
#define PROBE_DUP -1
#endif
#ifndef PROBE_META
#define PROBE_META 0
#endif
#ifndef PROBE_VAR
#define PROBE_VAR 0
#endif
#ifndef DBG_STOP
#define DBG_STOP 99
#endif
constexpr int NPH = 16;
constexpr int N_LAUNCHES = MK_N_LAUNCHES;
static_assert(N_LAUNCHES == 1 || N_LAUNCHES == NPH, "MK_N_LAUNCHES is 1 or NPH");
struct Args { const float* in[20]; float* out; unsigned char* ws; int ph_lo, ph_hi; };
__global__ void __launch_bounds__(NWAVES * 64, 2) fwd_kernel(Args args) {
    extern __shared__ __attribute__((aligned(16))) unsigned char lds[];
    Frame F;
    F.lds = (LAS unsigned char*)lds;
    F.MISC = (volatile LAS unsigned*)(F.lds + MISC_OFF);
    F.G = gridDim.x; { const int bx = blockIdx.x; F.vcu = (F.G % 8 == 0) ? (bx % 8) * (F.G / 8) + bx / 8 : bx; }
    unsigned char* ws = args.ws; F.ws = ws;
    F.ctl = (gu32*)(ws + WS_CTL);
    F.x = args.in[0]; F.meta = args.in[1]; F.n1 = args.in[2]; F.w1g = args.in[3]; F.w1u = args.in[4]; F.w1d = args.in[5]; F.nm = args.in[6]; F.win = args.in[7];
    F.wlr = args.in[8]; F.blr = args.in[9]; F.gn = args.in[10]; F.wa = args.in[11]; F.wb = args.in[12]; F.wo = args.in[13]; F.rb = args.in[14]; F.n2 = args.in[15];
    F.w2g = args.in[16]; F.w2u = args.in[17]; F.w2d = args.in[18]; F.nf = args.in[19]; F.out = args.out;
    for (int u = threadIdx.x; u < (LDS_BYTES - LDSCTL_OFF) / 4; u += NWAVES * 64) ((LAS unsigned*)(F.lds + LDSCTL_OFF))[u] = 0u;
    __syncthreads();
    XcdBarrier bar; bar.bar = (unsigned*)(F.ctl + CW_BAR); bar.x = 0; bar.st = nullptr;
    if (N_LAUNCHES == 1) bar = xcd_barrier_post((unsigned*)(F.ctl + CW_BAR), F.MISC + 8);
    const int lo = args.ph_lo, hi = args.ph_hi;
#define IN(k) (lo <= (k) && (k) < hi && (k) < DBG_STOP)
#define SEAM() do { if (N_LAUNCHES == 1) xcd_barrier(bar); } while (0)
    typedef pg8::bf16_t b16;
    b16* XN = (b16*)(ws + WS_XN);
    float* SSQA = (float*)(ws + WS_SSQA); float* SSQB = (float*)(ws + WS_SSQB); float* SSQC = (float*)(ws + WS_SSQC);

    if (IN(0)) { if (PROBE_DUP == 0) { p0_prologue(F); SEAM(); } p0_prologue(F); SEAM(); }
    if (IN(1)) {
        pg8::Gemm g{XN, (const b16*)(ws + WS_W1GU), NREAL, 5632, 1024, nullptr, nullptr}; pg8::StaticOrder S; S.init(NREAL, 5632, F.G, (int)blockIdx.x);
        pg8::EpiSwiglu E{(b16*)(ws + WS_HB), DFF, nullptr};
        pg8::gemm_phase<pg8::EpiSwiglu, pg8::StaticOrder, true, true>(F.lds + RING_OFF, g, S, E);
        if (PROBE_DUP == 1) { SEAM(); pg8::gemm_phase<pg8::EpiSwiglu, pg8::StaticOrder, true, true>(F.lds + RING_OFF, g, S, E); }
        meta_ffn1_gu(F, 128);
        SEAM();
    }
    if (IN(2)) {
        pg8::Gemm g{(const b16*)(ws + WS_HB), (const b16*)(ws + WS_W1D), NREAL, 1024, DFF, nullptr, nullptr}; pg8::StaticOrder S; S.init(NREAL, 1024, F.G, (int)blockIdx.x);
        pg8::EpiResid E{F.x, F.out, nullptr, nullptr, 0.5f, XN, F.nm, SSQA, NREAL};
        pg8::gemm_phase<pg8::EpiResid, pg8::StaticOrder, true, true>(F.lds + RING_OFF, g, S, E);
        if (PROBE_DUP == 2) { SEAM(); pg8::gemm_phase<pg8::EpiResid, pg8::StaticOrder, true, true>(F.lds + RING_OFF, g, S, E); }
        meta_ffn1_down(F, 0);
        SEAM();
    }
    pg8::EpiWin EW{SSQA, 0, (b16*)(ws + WS_GQ), (b16*)(ws + WS_GK), (b16*)(ws + WS_GV), (b16*)(ws + WS_GR), (b16*)(ws + WS_IQ), (b16*)(ws + WS_DQ), (b16*)(ws + WS_DKB), (b16*)(ws + WS_DVB),
                   (b16*)(ws + WS_GA), (b16*)(ws + WS_GB), (b16*)(ws + WS_IKB), (float*)(ws + WS_GLR), (float*)(ws + WS_IW)};
    if (IN(3)) {
        pg8::Gemm g{XN, (const b16*)(ws + WS_WIN), NREAL, 15 * 256, 1024, nullptr, nullptr}; pg8::StaticOrder S; S.init(NREAL, 15 * 256, F.G, (int)blockIdx.x);
        EW.ct0 = 0;
        pg8::gemm_phase<pg8::EpiWin, pg8::StaticOrder, true, true>(F.lds + RING_OFF, g, S, EW);
        if (PROBE_DUP == 3) { SEAM(); pg8::gemm_phase<pg8::EpiWin, pg8::StaticOrder, true, true>(F.lds + RING_OFF, g, S, EW); }
        meta_win_a(F, 192);
        SEAM();
    }
    if (IN(4)) { if (PROBE_DUP == 4) { gla_phase_a(F, true, PROBE_VAR); SEAM(); } gla_phase_a(F, false); SEAM(); }
    if (IN(5)) { if (PROBE_DUP == 5) { gla_phase_b(F); SEAM(); } gla_phase_b(F); SEAM(); }
    if (IN(6)) { if (PROBE_DUP == 6) { gla_phase_c(F, true); SEAM(); } gla_phase_c(F, false); SEAM(); }
    if (IN(7)) { if (PROBE_DUP == 7) { idx_phase(F, PROBE_VAR); SEAM(); } idx_phase(F); SEAM(); }
    if (IN(8)) {
        pg8::Gemm g{XN, (const b16*)(ws + WS_WIN) + (size_t)15 * 256 * 1024, NREAL, 12 * 256, 1024, nullptr, nullptr}; pg8::StaticOrder S; S.init(NREAL, 12 * 256, F.G, (int)blockIdx.x);
        EW.ct0 = 15;
        pg8::gemm_phase<pg8::EpiWin, pg8::StaticOrder, true, true>(F.lds + RING_OFF, g, S, EW);
        if (PROBE_DUP == 8) { SEAM(); pg8::gemm_phase<pg8::EpiWin, pg8::StaticOrder, true, true>(F.lds + RING_OFF, g, S, EW); }
        meta_win_b(F, 0);
        SEAM();
    }
    if (IN(9)) { if (PROBE_DUP == 9) { attn_phase(F, true); SEAM(); } attn_phase(F, false); SEAM(); }
    if (IN(10)) {
        pg8::Gemm g{XN, (const b16*)(ws + WS_WIN) + (size_t)27 * 256 * 1024, NREAL, 8 * 256, 1024, nullptr, nullptr}; pg8::StaticOrder S; S.init(NREAL, 8 * 256, F.G, (int)blockIdx.x);
        EW.ct0 = 27;
        pg8::gemm_phase<pg8::EpiWin, pg8::StaticOrder, true, true>(F.lds + RING_OFF, g, S, EW);
        if (PROBE_DUP == 10) { SEAM(); pg8::gemm_phase<pg8::EpiWin, pg8::StaticOrder, true, true>(F.lds + RING_OFF, g, S, EW); }
        SEAM();
    }
    if (IN(11)) {
        pg8::Gemm g{(const b16*)(ws + WS_GR), (const b16*)(ws + WS_WA), NREAL, 1024, 1024, (const b16*)(ws + WS_DQ), (const b16*)(ws + WS_WB)}; pg8::PairOrder S; S.init(NREAL, 1024, F.G, (int)blockIdx.x);
        pg8::EpiMerge E{(const b16*)(ws + WS_GA), (const b16*)(ws + WS_GB), XN};
        pg8::gemm_phase<pg8::EpiMerge, pg8::PairOrder, false, true>(F.lds + RING_OFF, g, S, E);
        if (PROBE_DUP == 11) { SEAM(); pg8::gemm_phase<pg8::EpiMerge, pg8::PairOrder, false, true>(F.lds + RING_OFF, g, S, E); }
        SEAM();
    }
    if (IN(12)) {
        pg8::Gemm g{XN, (const b16*)(ws + WS_WO), NREAL, 1024, 1024, nullptr, nullptr}; pg8::StaticOrder S; S.init(NREAL, 1024, F.G, (int)blockIdx.x);
        pg8::EpiResid E{F.out, F.out, nullptr, nullptr, 1.0f, (b16*)(ws + WS_A3), F.n2, SSQB, NREAL};
        pg8::gemm_phase<pg8::EpiResid, pg8::StaticOrder, true, true>(F.lds + RING_OFF, g, S, E);
        SEAM();
    }
    if (IN(13)) {
        pg8::Gemm g{(const b16*)(ws + WS_A3), (const b16*)(ws + WS_W2GU), NREAL, 5632, 1024, nullptr, nullptr}; pg8::StaticOrder S; S.init(NREAL, 5632, F.G, (int)blockIdx.x);
        pg8::EpiSwiglu E{(b16*)(ws + WS_HB2), DFF, SSQB};
        pg8::gemm_phase<pg8::EpiSwiglu, pg8::StaticOrder, true, true>(F.lds + RING_OFF, g, S, E);
        if (PROBE_DUP == 13) { SEAM(); pg8::gemm_phase<pg8::EpiSwiglu, pg8::StaticOrder, true, true>(F.lds + RING_OFF, g, S, E); }
        SEAM();
    }
    if (IN(14)) {
        pg8::Gemm g{(const b16*)(ws + WS_HB2), (const b16*)(ws + WS_W2D), NREAL, 1024, DFF, nullptr, nullptr}; pg8::StaticOrder S; S.init(NREAL, 1024, F.G, (int)blockIdx.x);
        pg8::EpiResid E{F.out, F.out, nullptr, nullptr, 0.5f, nullptr, nullptr, SSQC, NREAL};
        pg8::gemm_phase<pg8::EpiResid, pg8::StaticOrder, true, true>(F.lds + RING_OFF, g, S, E);
        SEAM();
    }

    if (lo <= 15 && 15 < hi) { p_final(F, DBG_STOP <= 12 ? SSQA : (DBG_STOP <= 14 ? SSQB : SSQC)); }
#undef IN
#undef SEAM
}

extern "C" void kernel_launch(void* const* d_in, const int* in_sizes, int n_in, void* d_out, int out_size, void* d_ws, size_t ws_size, hipStream_t stream) {
    static int grid = 0;
    if (grid == 0) {
        if (n_in != 20 || out_size != NREAL * DM || ws_size < WS_END) { fprintf(stderr, "kernel_launch: unexpected shapes: n_in %d out %d ws %zu\n", n_in, out_size, ws_size); grid = -1; return; }
        int dev = 0, cus = 0, per_cu = 0;
        if (hipGetDevice(&dev) != hipSuccess || hipDeviceGetAttribute(&cus, hipDeviceAttributeMultiprocessorCount, dev) != hipSuccess) { grid = -1; return; }
        if (hipFuncSetAttribute((const void*)fwd_kernel, hipFuncAttributeMaxDynamicSharedMemorySize, LDS_BYTES) != hipSuccess) { fprintf(stderr, "kernel_launch: hipFuncSetAttribute failed\n"); grid = -1; return; }
        if (hipOccupancyMaxActiveBlocksPerMultiprocessor(&per_cu, (const void*)fwd_kernel, NWAVES * 64, LDS_BYTES) != hipSuccess || per_cu < 1)
            fprintf(stderr, "kernel_launch: note: occupancy query reports %d workgroups per CU\n", per_cu);
        (void)hipGetLastError();
        grid = cus;
        if (grid > 256) grid = 256;
    }
    if (grid < 0) return;
    if (hipMemsetAsync((char*)d_ws + WS_CTL, 0, CTL_ZERO_BYTES, stream) != hipSuccess) { fprintf(stderr, "kernel_launch: memset failed\n"); return; }
    Args a{};
    for (int i = 0; i < 20; ++i) a.in[i] = (const float*)d_in[i];
    a.out = (float*)d_out; a.ws = (unsigned char*)d_ws;
    for (int li = 0; li < N_LAUNCHES; ++li) {
        a.ph_lo = (N_LAUNCHES == 1) ? 0 : li; a.ph_hi = (N_LAUNCHES == 1) ? NPH : li + 1;
        hipLaunchKernelGGL(fwd_kernel, dim3(grid), dim3(NWAVES * 64), LDS_BYTES, stream, a);
        const hipError_t le = hipPeekAtLastError();
        if (le != hipSuccess) { fprintf(stderr, "kernel_launch: launch %d failed: %s\n", li, hipGetErrorName(le)); break; }
    }
}
```
